# Optimizing an MI355X kernel written in HIP

```python
import math
import jax
import jax.numpy as jnp
from jax import lax
import numpy as np

D_MODEL = 1024
BATCH = 8
SEQ = 4096
DEPTH = 4

HEAD_DIM = 64
MIX_WIDTH = 1024
A_HEADS = 4
A_KV_HEADS = 2
B_HEADS = 4
B_QK_DIM = 32
B_V_DIM = 64
C_HEADS = 4
C_Q_LORA = 256
C_KV_LORA = 128
C_NOPE = 64
C_ROPE = 32
C_V_DIM = 64
D_HEADS = 4
DILATED_CONFIGS = ((128, 1), (512, 4), (2048, 16))
D_FF = 2816
GRID_W = 64
Q_BLOCK = 128
ROPE_THETA = 10000.0
NORM_EPS = 1e-6

IN_SPLITS = (
    A_HEADS * HEAD_DIM, A_KV_HEADS * HEAD_DIM, A_KV_HEADS * HEAD_DIM,
    B_HEADS * 2 * B_QK_DIM, B_HEADS * 2 * B_QK_DIM, B_HEADS * B_V_DIM,
    C_Q_LORA, C_KV_LORA, C_ROPE,
    D_HEADS * HEAD_DIM, D_HEADS * HEAD_DIM, D_HEADS * HEAD_DIM,
)
IN_WIDTH = sum(IN_SPLITS)

kernel_name = 'hybrid_parallel_heads_encoder'


def _rmsnorm(x, g):
    xf = x.astype(jnp.float32)
    y = xf * lax.rsqrt(jnp.mean(xf * xf, axis=-1, keepdims=True) + NORM_EPS)
    return (y * g.astype(jnp.float32)).astype(x.dtype)


def _split_cols(a, sizes):
    parts, off = [], 0
    for n in sizes:
        parts.append(a[..., off:off + n])
        off += n
    return parts


def _heads(a, n_heads):
    b, s, _ = a.shape
    return a.reshape(b, s, n_heads, -1).transpose(0, 2, 1, 3)


def _rope_freqs(dim):
    return 1.0 / (ROPE_THETA ** (jnp.arange(0, dim, 2, dtype=jnp.float32) / dim))


def _rotate(x, ang):
    n = ang.shape[-1]
    x1 = x[..., :n].astype(jnp.float32)
    x2 = x[..., n:].astype(jnp.float32)
    c, s = jnp.cos(ang), jnp.sin(ang)
    return jnp.concatenate([x1 * c - x2 * s, x1 * s + x2 * c], axis=-1).astype(x.dtype)


def _axial_rope(x, ang_row, ang_col):
    half = x.shape[-1] // 2
    return jnp.concatenate([_rotate(x[..., :half], ang_row), _rotate(x[..., half:], ang_col)], axis=-1)


def _alibi_slopes(n):
    return 2.0 ** (-8.0 * jnp.arange(1, n + 1, dtype=jnp.float32) / n)


def _to_blocks(a):
    *lead, s, d = a.shape
    return jnp.moveaxis(a.reshape(*lead, s // Q_BLOCK, Q_BLOCK, d), -3, 0)


def _from_blocks(a):
    a = jnp.moveaxis(a, 0, -3)
    *lead, nb, qb, d = a.shape
    return a.reshape(*lead, nb * qb, d)


def _dense_attention(q, k, v, scale):
    def block(qb):
        s = jnp.einsum('bhgqd,bhkd->bhgqk', qb, k).astype(jnp.float32) * scale
        p = jax.nn.softmax(s, axis=-1)
        return jnp.einsum('bhgqk,bhkd->bhgqd', p.astype(v.dtype), v)
    return _from_blocks(lax.map(block, _to_blocks(q)))


def _diff_attention(q1, q2, k1, k2, v, lam, slopes, scale):
    s_len = k1.shape[-2]
    kpos = jnp.arange(s_len)

    def block(args):
        q1b, q2b, qpos = args
        dist = jnp.abs(qpos[:, None] - kpos[None, :]).astype(jnp.float32)
        bias = -slopes[:, None, None] * dist
        a1 = jax.nn.softmax(jnp.einsum('bhqd,bhkd->bhqk', q1b, k1).astype(jnp.float32) * scale + bias, axis=-1)
        a2 = jax.nn.softmax(jnp.einsum('bhqd,bhkd->bhqk', q2b, k2).astype(jnp.float32) * scale + bias, axis=-1)
        return jnp.einsum('bhqk,bhkd->bhqd', (a1 - lam * a2).astype(v.dtype), v)

    qpos = jnp.arange(s_len).reshape(-1, Q_BLOCK)
    return _from_blocks(lax.map(block, (_to_blocks(q1), _to_blocks(q2), qpos)))


def _banded_attention(q, k, v, radius, step, slopes, scale):
    b, h, r, l_len, dh = q.shape
    qb = min(Q_BLOCK, l_len)
    nb = -(-l_len // qb)
    lp = nb * qb

    def pad(a, lo, hi):
        return jnp.pad(a, ((0, 0), (0, 0), (0, 0), (lo, hi), (0, 0)))

    qp = pad(q, 0, lp - l_len).reshape(b, h, r, nb, qb, dh)
    kp = pad(k, radius, lp - l_len + radius)
    vp = pad(v, radius, lp - l_len + radius)
    band = jnp.arange(nb)[:, None] * qb + jnp.arange(qb + 2 * radius)[None, :]
    kb = kp[:, :, :, band]
    vb = vp[:, :, :, band]
    qpos = jnp.arange(lp).reshape(nb, qb)
    kpos = band - radius
    rel = jnp.abs(qpos[:, :, None] - kpos[:, None, :])
    in_range = ((kpos >= 0) & (kpos < l_len))[:, None, :]
    allowed = (rel <= radius) & (in_range | (rel == 0))
    s = jnp.einsum('bhrnqd,bhrnkd->bhrnqk', qp, kb).astype(jnp.float32) * scale
    s = s - slopes[:, None, None, None, None] * (rel * step).astype(jnp.float32)
    s = jnp.where(allowed, s, -jnp.inf)
    lse = jax.nn.logsumexp(s, axis=-1, keepdims=True)
    p = jnp.exp(s - lse)
    out = jnp.einsum('bhrnqk,bhrnkd->bhrnqd', p.astype(v.dtype), vb)
    out = out.reshape(b, h, r, lp, dh)[:, :, :, :l_len]
    lse = lse.reshape(b, h, r, lp)[:, :, :, :l_len]
    return out, lse


def _dilated_attention(q, k, v, slopes, scale):
    b, h, s_len, dh = q.shape
    outs, lses = [], []
    for window, dilation in DILATED_CONFIGS:
        l_len = s_len // dilation

        def by_residue(a):
            return a.reshape(b, h, l_len, dilation, dh).transpose(0, 1, 3, 2, 4)

        o, lse = _banded_attention(by_residue(q), by_residue(k), by_residue(v),
                                   window // (2 * dilation), dilation, slopes, scale)
        outs.append(o.transpose(0, 1, 3, 2, 4).reshape(b, h, s_len, dh))
        lses.append(lse.transpose(0, 1, 3, 2).reshape(b, h, s_len))
    w = jax.nn.softmax(jnp.stack(lses), axis=0)
    out = jnp.sum(w[..., None] * jnp.stack(outs).astype(jnp.float32), axis=0)
    return out.astype(q.dtype)


def _dwconv3(u, w, bias):
    up = jnp.pad(u, ((0, 0), (1, 1), (0, 0)))
    return up[:, :-2] * w[0] + up[:, 1:-1] * w[1] + up[:, 2:] * w[2] + bias


def setup_inputs(seed: int = 0) -> dict:
    key = jax.random.key(seed)
    ks = jax.random.split(key, 26)
    f32 = jnp.float32

    def nrm(k, shape, fan_in):
        return jax.random.normal(k, shape, f32) * fan_in ** -0.5

    def gain(k, n):
        return 1.0 + 0.02 * jax.random.normal(k, (DEPTH, n), f32)

    return {
        'x': jax.random.normal(ks[0], (BATCH, SEQ, D_MODEL), f32),
        'norm1_g': gain(ks[1], D_MODEL),
        'w_in': nrm(ks[2], (DEPTH, D_MODEL, IN_WIDTH), D_MODEL),
        'a_qn_g': gain(ks[3], HEAD_DIM),
        'a_kn_g': gain(ks[4], HEAD_DIM),
        'b_qn_g': gain(ks[5], B_QK_DIM),
        'b_kn_g': gain(ks[6], B_QK_DIM),
        'b_lam_q1': 0.1 * jax.random.normal(ks[7], (DEPTH, B_QK_DIM), f32),
        'b_lam_k1': 0.1 * jax.random.normal(ks[8], (DEPTH, B_QK_DIM), f32),
        'b_lam_q2': 0.1 * jax.random.normal(ks[9], (DEPTH, B_QK_DIM), f32),
        'b_lam_k2': 0.1 * jax.random.normal(ks[10], (DEPTH, B_QK_DIM), f32),
        'b_sub_g': gain(ks[11], B_V_DIM),
        'c_qa_g': gain(ks[12], C_Q_LORA),
        'c_kva_g': gain(ks[13], C_KV_LORA),
        'c_wqb': nrm(ks[14], (DEPTH, C_Q_LORA, C_HEADS * (C_NOPE + C_ROPE)), C_Q_LORA),
        'c_wkvb': nrm(ks[15], (DEPTH, C_KV_LORA, C_HEADS * (C_NOPE + C_V_DIM)), C_KV_LORA),
        'c_qn_g': gain(ks[16], C_NOPE + C_ROPE),
        'c_kn_g': gain(ks[17], C_NOPE + C_ROPE),
        'd_qn_g': gain(ks[18], HEAD_DIM),
        'd_kn_g': gain(ks[19], HEAD_DIM),
        'w_out': nrm(ks[20], (DEPTH, MIX_WIDTH, D_MODEL), MIX_WIDTH),
        'norm2_g': gain(ks[21], D_MODEL),
        'w_up': nrm(ks[22], (DEPTH, D_MODEL, 2 * D_FF), D_MODEL),
        'conv_w': nrm(ks[23], (DEPTH, 3, 2 * D_FF), 3),
        'conv_b': 0.02 * jax.random.normal(ks[24], (DEPTH, 2 * D_FF), f32),
        'w_down': nrm(ks[25], (DEPTH, D_FF, D_MODEL), D_FF),
    }


def reference(x, norm1_g, w_in, a_qn_g, a_kn_g, b_qn_g, b_kn_g, b_lam_q1, b_lam_k1,
              b_lam_q2, b_lam_k2, b_sub_g, c_qa_g, c_kva_g, c_wqb, c_wkvb, c_qn_g, c_kn_g,
              d_qn_g, d_kn_g, w_out, norm2_g, w_up, conv_w, conv_b, w_down):
    b, s_len, _ = x.shape
    n_rows = s_len // GRID_W
    rows, cols = jnp.meshgrid(jnp.arange(n_rows), jnp.arange(GRID_W), indexing='ij')
    rows = rows.reshape(-1).astype(jnp.float32)
    cols = cols.reshape(-1).astype(jnp.float32)
    pos = jnp.arange(s_len, dtype=jnp.float32)
    ax_freq = _rope_freqs(HEAD_DIM // 2)
    ang_row = rows[:, None] * ax_freq
    ang_col = cols[:, None] * ax_freq
    ang_mla = pos[:, None] * _rope_freqs(C_ROPE)
    slopes = _alibi_slopes(B_HEADS + D_HEADS)
    slopes_b, slopes_d = slopes[:B_HEADS], slopes[B_HEADS:]

    for l in range(DEPTH):
        h = _rmsnorm(x, norm1_g[l])
        proj = h @ w_in[l]
        (aq, ak, av, bq, bk, bv, cql, ckvl, ckr, dq, dk, dv) = _split_cols(proj, IN_SPLITS)

        qa = _axial_rope(_rmsnorm(_heads(aq, A_HEADS), a_qn_g[l]), ang_row, ang_col)
        ka = _axial_rope(_rmsnorm(_heads(ak, A_KV_HEADS), a_kn_g[l]), ang_row, ang_col)
        qa = qa.reshape(b, A_KV_HEADS, A_HEADS // A_KV_HEADS, s_len, HEAD_DIM)
        oa = _dense_attention(qa, ka, _heads(av, A_KV_HEADS), HEAD_DIM ** -0.5)
        oa = oa.reshape(b, A_HEADS, s_len, HEAD_DIM)

        qb = _heads(bq, B_HEADS)
        kb = _heads(bk, B_HEADS)
        q1 = _rmsnorm(qb[..., :B_QK_DIM], b_qn_g[l])
        q2 = _rmsnorm(qb[..., B_QK_DIM:], b_qn_g[l])
        k1 = _rmsnorm(kb[..., :B_QK_DIM], b_kn_g[l])
        k2 = _rmsnorm(kb[..., B_QK_DIM:], b_kn_g[l])
        lam_init = 0.8 - 0.6 * math.exp(-0.3 * l)
        lam = (jnp.exp(jnp.sum(b_lam_q1[l] * b_lam_k1[l]).astype(jnp.float32))
               - jnp.exp(jnp.sum(b_lam_q2[l] * b_lam_k2[l]).astype(jnp.float32)) + lam_init)
        ob = _diff_attention(q1, q2, k1, k2, _heads(bv, B_HEADS), lam, slopes_b, B_QK_DIM ** -0.5)
        ob = _rmsnorm(ob, b_sub_g[l]) * (1.0 - lam_init)

        qc = _heads(_rmsnorm(cql, c_qa_g[l]) @ c_wqb[l], C_HEADS)
        kvc = _heads(_rmsnorm(ckvl, c_kva_g[l]) @ c_wkvb[l], C_HEADS)
        k_nope, vc = kvc[..., :C_NOPE], kvc[..., C_NOPE:]
        k_rope = jnp.broadcast_to(ckr[:, None], (b, C_HEADS, s_len, C_ROPE))
        kc = jnp.concatenate([k_nope, k_rope], axis=-1)
        qc = _rmsnorm(qc, c_qn_g[l])
        kc = _rmsnorm(kc, c_kn_g[l])
        qc = jnp.concatenate([qc[..., :C_NOPE], _rotate(qc[..., C_NOPE:], ang_mla)], axis=-1)
        kc = jnp.concatenate([kc[..., :C_NOPE], _rotate(kc[..., C_NOPE:], ang_mla)], axis=-1)
        oc = _dense_attention(qc[:, :, None], kc, vc, (C_NOPE + C_ROPE) ** -0.5)[:, :, 0]

        qd = _rmsnorm(_heads(dq, D_HEADS), d_qn_g[l])
        kd = _rmsnorm(_heads(dk, D_HEADS), d_kn_g[l])
        od = _dilated_attention(qd, kd, _heads(dv, D_HEADS), slopes_d, HEAD_DIM ** -0.5)

        mix = jnp.concatenate([oa, ob, oc, od], axis=1)
        mix = mix.transpose(0, 2, 1, 3).reshape(b, s_len, MIX_WIDTH)
        x = x + mix @ w_out[l]

        h = _rmsnorm(x, norm2_g[l])
        u = _dwconv3(h @ w_up[l], conv_w[l], conv_b[l])
        gate, val = u[..., :D_FF], u[..., D_FF:]
        x = x + (jax.nn.silu(gate) * val) @ w_down[l]
    return x
```

```cpp
#include <hip/hip_runtime.h>
#include <hip/hip_cooperative_groups.h>
#include <cstdio>
#include <cstdint>
namespace cg = cooperative_groups;

#define LAS __attribute__((address_space(3)))
typedef unsigned short u16;
typedef short bf16x8 __attribute__((ext_vector_type(8)));
typedef float f32x4 __attribute__((ext_vector_type(4)));
typedef float f32x16 __attribute__((ext_vector_type(16)));
typedef unsigned u32x4 __attribute__((ext_vector_type(4)));
typedef unsigned u32x2 __attribute__((ext_vector_type(2)));

constexpr int NTOK = 32768, SEQ = 4096, NB = 8, DM = 1024, DEPTH = 4;
constexpr int INW = 2464, INWP = 2560, DFF = 2816;
constexpr float EPS = 1e-6f;
constexpr float LOG2E = 1.4426950408889634f;
constexpr int LDS_BYTES = 131072 + 64;
constexpr int NTHR = 512;

enum { I_X = 0, I_N1G, I_WIN, I_AQN, I_AKN, I_BQN, I_BKN, I_LQ1, I_LK1, I_LQ2, I_LK2, I_BSUB, I_CQAG, I_CKVAG, I_WQB, I_WKVB, I_CQN, I_CKN,
       I_DQN, I_DKN, I_WOUT, I_N2G, I_WUP, I_CONVW, I_CONVB, I_WDOWN };

constexpr size_t WS_BT_IN = 0;
constexpr size_t WS_BT_MLA = WS_BT_IN + (size_t)INWP * 1024 * 2;
constexpr size_t WS_BT_OUT = WS_BT_MLA + (size_t)1024 * 512 * 2;
constexpr size_t WS_BT_UP = WS_BT_OUT + (size_t)1024 * 1024 * 2;
constexpr size_t WS_BT_DN = WS_BT_UP + (size_t)5632 * 1024 * 2;
constexpr size_t WS_ROPE = WS_BT_DN + (size_t)1024 * 2816 * 2;
constexpr size_t WS_LD = WS_ROPE + (size_t)4096 * 16 * 8;
constexpr size_t WS_XN = WS_LD + (size_t)3 * NTOK * 4 * 4;
constexpr size_t WS_R1 = WS_XN + (size_t)NTOK * 1024 * 2;
constexpr size_t WS_MIX = WS_XN;
constexpr size_t WS_QKV = WS_R1 + (size_t)NTOK * INWP * 2;
constexpr size_t QKV_TOK = (size_t)NTOK * 2;
constexpr size_t WS_QA = WS_QKV;
constexpr size_t WS_KA = WS_QA + 256 * QKV_TOK;
constexpr size_t WS_VTA = WS_KA + 128 * QKV_TOK;
constexpr size_t WS_QB = WS_VTA + 128 * QKV_TOK;
constexpr size_t WS_KB = WS_QB + 256 * QKV_TOK;
constexpr size_t WS_VTB = WS_KB + 256 * QKV_TOK;
constexpr size_t WS_QC = WS_VTB + 256 * QKV_TOK;
constexpr size_t WS_KC = WS_QC + 384 * QKV_TOK;
constexpr size_t WS_VTC = WS_KC + 384 * QKV_TOK;
constexpr size_t WS_QD = WS_VTC + 256 * QKV_TOK;
constexpr size_t WS_KD = WS_QD + 256 * QKV_TOK;
constexpr size_t WS_VTD = WS_KD + 256 * QKV_TOK;
constexpr size_t WS_END = WS_VTD + 768 * QKV_TOK;
constexpr size_t WS_ACT = WS_R1;
constexpr size_t WS_HB = WS_ACT + (size_t)NTOK * 2816 * 2;
static_assert(WS_HB + (size_t)512 * 4 * 5632 * 2 <= WS_END, "ffn overlay");
static_assert(WS_END <= (size_t)536870912, "workspace");

constexpr int TICKET_WORD0 = 3456;
constexpr size_t WS_BAR = WS_END;
__host__ __device__ constexpr size_t dpart_off(int br) { return br == 0 ? WS_QA : (br == 1 ? WS_QB : WS_QD); }
struct Params {
    const float* in[26];
    float* out;
    unsigned char* ws;
};

typedef __bf16 bf16x2_t __attribute__((ext_vector_type(2)));
typedef float f32x2_t __attribute__((ext_vector_type(2)));
__device__ __forceinline__ unsigned cvt_pk_bf16(float lo, float hi) { f32x2_t v = {lo, hi}; bf16x2_t b = __builtin_convertvector(v, bf16x2_t); return __builtin_bit_cast(unsigned, b); }
__device__ __forceinline__ float bf_lo(unsigned w) { return __uint_as_float(w << 16); }
__device__ __forceinline__ float bf_hi(unsigned w) { return __uint_as_float(w & 0xffff0000u); }
__device__ __forceinline__ float wave_sum(float v) {
#pragma unroll
    for (int o = 1; o < 64; o <<= 1) v += __shfl_xor(v, o);
    return v;
}
__device__ __forceinline__ float wave_max(float v) {
#pragma unroll
    for (int o = 1; o < 64; o <<= 1) v = fmaxf(v, __shfl_xor(v, o));
    return v;
}
__device__ __forceinline__ float wave_absmax(const float* g, int n, int lane) {
    float v = lane < n ? fabsf(g[lane]) : 0.f;
    if (lane + 64 < n) v = fmaxf(v, fabsf(g[lane + 64]));
    return wave_max(v);
}
template <int N8> __device__ __forceinline__ void load_bf16_vec(const u16* src, float* v) {
#pragma unroll
    for (int c = 0; c < N8; ++c) {
        const u32x4 w = *(const u32x4*)(src + 8 * c);
        v[8 * c + 0] = bf_lo(w.x); v[8 * c + 1] = bf_hi(w.x); v[8 * c + 2] = bf_lo(w.y); v[8 * c + 3] = bf_hi(w.y);
        v[8 * c + 4] = bf_lo(w.z); v[8 * c + 5] = bf_hi(w.z); v[8 * c + 6] = bf_lo(w.w); v[8 * c + 7] = bf_hi(w.w);
    }
}
template <int N8> __device__ __forceinline__ void store_bf16_vec(u16* dst, const float* v) {
#pragma unroll
    for (int c = 0; c < N8; ++c) {
        u32x4 w;
        w.x = cvt_pk_bf16(v[8 * c + 0], v[8 * c + 1]); w.y = cvt_pk_bf16(v[8 * c + 2], v[8 * c + 3]);
        w.z = cvt_pk_bf16(v[8 * c + 4], v[8 * c + 5]); w.w = cvt_pk_bf16(v[8 * c + 6], v[8 * c + 7]);
        *(u32x4*)(dst + 8 * c) = w;
    }
}
template <int N8> __device__ __forceinline__ float sumsq_bf16(const u16* src) {
    float s = 0.f;
#pragma unroll
    for (int c = 0; c < N8; ++c) {
        const u32x4 w = *(const u32x4*)(src + 8 * c);
        float a;
        a = bf_lo(w.x); s += a * a; a = bf_hi(w.x); s += a * a; a = bf_lo(w.y); s += a * a; a = bf_hi(w.y); s += a * a;
        a = bf_lo(w.z); s += a * a; a = bf_hi(w.z); s += a * a; a = bf_lo(w.w); s += a * a; a = bf_hi(w.w); s += a * a;
    }
    return s;
}

namespace g8 {
constexpr int BM = 256, BK = 64, HALF = 128, HTB = HALF * BK * 2, NXCD = 8, WGM = 8;
__device__ __forceinline__ int lds_byte(int r, int c) { const int st = (r >> 4) * 2 + (c >> 5), rr = r & 15, cc = c & 31, ob = rr * 64 + cc * 2; return st * 1024 + (ob ^ (((ob >> 9) & 1) << 5)); }
__device__ __forceinline__ void stage_rc(int b, int& R, int& C) { const int st = b / 1024, sb = b % 1024, swz = sb ^ (((sb >> 9) & 1) << 5); R = (st >> 1) * 16 + swz / 64; C = (st & 1) * 32 + (swz % 64) / 2; }

__device__ __forceinline__ int perm32(int rho) { const int n = rho >> 4, i = rho & 15; return 8 * (i >> 2) + 4 * n + (i & 3); }
__device__ __forceinline__ bool unit_at(int i, int G, int c, int nM, int nN, int& pm, int& pn) {
    const int nwg = nM * nN; const long Lx = (long)i * G + c; if (Lx >= nwg) return false;
    int wgid = (int)Lx; { const int q = nwg / NXCD, r = nwg % NXCD, xcd = wgid % NXCD, off = wgid / NXCD; wgid = (xcd < r ? xcd * (q + 1) : r * (q + 1) + (xcd - r) * q) + off; }
    const int nig = WGM * nN, gid = wgid / nig, fm = gid * WGM, gsz = (nM - fm) < WGM ? (nM - fm) : WGM;
    pm = fm + ((wgid % nig) % gsz); pn = (wgid % nig) / gsz; return true;
}

struct EpiBf16 {
    static constexpr bool PERM = true;
    u16* O; int ldc;
    __device__ __forceinline__ void operator()(const f32x4 (&acc)[2][2][4][2], int brow, int bcol, int wr, int wc, int fr, int fq) const {
#pragma unroll
        for (int ai = 0; ai < 2; ++ai)
#pragma unroll
            for (int m = 0; m < 4; ++m) {
                u16* rowp = O + (size_t)(brow + ai * HALF + wr * 64 + m * 16 + fr) * ldc + bcol + wc * 32 + 8 * fq;
#pragma unroll
                for (int bj = 0; bj < 2; ++bj) {
                    const f32x4 v0 = acc[ai][bj][m][0], v1 = acc[ai][bj][m][1];
                    u32x4 w; w.x = cvt_pk_bf16(v0[0], v0[1]); w.y = cvt_pk_bf16(v0[2], v0[3]); w.z = cvt_pk_bf16(v1[0], v1[1]); w.w = cvt_pk_bf16(v1[2], v1[3]);
                    *(u32x4*)(rowp + bj * HALF) = w;
                }
            }
    }
};
struct EpiRes {
    static constexpr bool PERM = false;
    const float* xin; float* xout;
    __device__ __forceinline__ void operator()(const f32x4 (&acc)[2][2][4][2], int brow, int bcol, int wr, int wc, int fr, int fq) const {
#pragma unroll
        for (int ai = 0; ai < 2; ++ai)
#pragma unroll
            for (int m = 0; m < 4; ++m) {
                const size_t off = (size_t)(brow + ai * HALF + wr * 64 + m * 16 + fr) * 1024 + bcol + wc * 32 + 4 * fq;
#pragma unroll
                for (int bj = 0; bj < 2; ++bj)
#pragma unroll
                    for (int n = 0; n < 2; ++n) {
                        const f32x4 b = *(const f32x4*)(xin + off + bj * HALF + n * 16);
                        *(f32x4*)(xout + off + bj * HALF + n * 16) = b + acc[ai][bj][m][n];
                    }
            }
    }
};

__device__ __forceinline__ float dpp_from_prev(float v) { return __int_as_float(__builtin_amdgcn_update_dpp(0, __float_as_int(v), 0x121  , 0xf, 0xf, false)); }
__device__ __forceinline__ float dpp_from_next(float v) { return __int_as_float(__builtin_amdgcn_update_dpp(0, __float_as_int(v), 0x12F  , 0xf, 0xf, false)); }
struct EpiConv {
    static constexpr bool PERM = false;
    u16* act; u16* hb; const float* cw; const float* cb;
    __device__ __forceinline__ void operator()(const f32x4 (&acc)[2][2][4][2], int brow, int bcol, int wr, int wc, int fr, int fq) const {
        const int lane = fq * 16 + fr, lup = fq * 16 + ((fr + 15) & 15), ldn = fq * 16 + ((fr + 1) & 15);
        const int pn = bcol >> 8;
#pragma unroll
        for (int n = 0; n < 2; ++n) {
            const int cg = 128 * pn + wc * 32 + n * 16 + 4 * fq;
            const f32x4 w0g = *(const f32x4*)(cw + cg), w1g = *(const f32x4*)(cw + 5632 + cg), w2g = *(const f32x4*)(cw + 2 * 5632 + cg), bg = *(const f32x4*)(cb + cg);
            const f32x4 w0v = *(const f32x4*)(cw + DFF + cg), w1v = *(const f32x4*)(cw + 5632 + DFF + cg), w2v = *(const f32x4*)(cw + 2 * 5632 + DFF + cg), bv = *(const f32x4*)(cb + DFF + cg);
#pragma unroll
            for (int ai = 0; ai < 2; ++ai) {
                const int rblk = brow + ai * HALF + wr * 64;
                f32x4 Rgp, Rvp, Lgc, Lvc;
#pragma unroll
                for (int j = 0; j < 4; ++j) { Lgc[j] = dpp_from_next(acc[ai][0][0][n][j]); Lvc[j] = dpp_from_next(acc[ai][1][0][n][j]); Rgp[j] = 0.f; Rvp[j] = 0.f; }
#pragma unroll
                for (int m = 0; m < 4; ++m) {
                    const f32x4 G = acc[ai][0][m][n], V = acc[ai][1][m][n];
                    f32x4 Rgc, Rvc, Lgn = Lgc, Lvn = Lvc;
#pragma unroll
                    for (int j = 0; j < 4; ++j) { Rgc[j] = dpp_from_prev(G[j]); Rvc[j] = dpp_from_prev(V[j]); }
                    if (m < 3) {
#pragma unroll
                        for (int j = 0; j < 4; ++j) { Lgn[j] = dpp_from_next(acc[ai][0][m < 3 ? m + 1 : 3][n][j]); Lvn[j] = dpp_from_next(acc[ai][1][m < 3 ? m + 1 : 3][n][j]); }
                    }
                    const f32x4 upg = fr > 0 ? Rgc : Rgp, upv = fr > 0 ? Rvc : Rvp;
                    const f32x4 dng = fr < 15 ? Lgc : Lgn, dnv = fr < 15 ? Lvc : Lvn;
                    const f32x4 ug = upg * w0g + G * w1g + dng * w2g + bg;
                    const f32x4 uv = upv * w0v + V * w1v + dnv * w2v + bv;
                    f32x4 o;
#pragma unroll
                    for (int j = 0; j < 4; ++j) o[j] = ug[j] * __builtin_amdgcn_rcpf(1.f + __expf(-ug[j])) * uv[j];
                    const int row = rblk + m * 16 + fr;
                    const bool seam = (m == 0 && fr == 0) || (m == 3 && fr == 15);
                    if (!seam) { u32x2 w; w.x = cvt_pk_bf16(o[0], o[1]); w.y = cvt_pk_bf16(o[2], o[3]); *(u32x2*)(act + (size_t)row * DFF + cg) = w; }
                    if ((m == 0 && fr < 2) || (m == 3 && fr > 13)) {
                        const int which = m == 0 ? fr : fr - 12;
                        u16* hp = hb + ((size_t)(row >> 6) * 4 + which) * 5632 + bcol + wc * 32 + n * 16 + 4 * fq;
                        u32x2 wg, wv; wg.x = cvt_pk_bf16(G[0], G[1]); wg.y = cvt_pk_bf16(G[2], G[3]); wv.x = cvt_pk_bf16(V[0], V[1]); wv.y = cvt_pk_bf16(V[2], V[3]);
                        *(u32x2*)hp = wg; *(u32x2*)(hp + HALF) = wv;
                    }
                    Rgp = Rgc; Rvp = Rvc; Lgc = Lgn; Lvc = Lvn;
                    asm volatile("" ::: "memory");
                }
                asm volatile("" ::: "memory");
            }
        }
        (void)lane;
    }
};

template <class Epi>
__device__ __forceinline__ void gemm_phase(LAS unsigned char* lds, int tid_in, const u16* A, int lda, const u16* Bt, int K, int nM, int nN, const Epi& E) {
    const int tid = tid_in, wid = __builtin_amdgcn_readfirstlane(tid >> 6), lane = tid & 63, wr = wid >> 2, wc = wid & 3, fr = lane & 15, fq = lane >> 4;
    const int nt = K / BK;
    unsigned offA[2], offB[2];
#pragma unroll
    for (int i = 0; i < 2; ++i) { int R, C; stage_rc(tid * 16 + i * 8192, R, C); const int Rb = Epi::PERM ? ((R & ~31) + perm32(R & 31)) : R; offA[i] = (unsigned)(R * lda + C); offB[i] = (unsigned)(Rb * K + C); }
    const unsigned ldsw = (unsigned)wid * 1024u;
    const int aoff = lds_byte(wr * 64 + fr, fq * 8), boff = lds_byte(wc * 32 + fr, fq * 8);
#define G8_SA(b, h) (((b) * 2 + (h)) * HTB)
#define G8_SB(b, h) ((4 + (b) * 2 + (h)) * HTB)
#define G8_STAGE(bufoff, gptr, voff) do { _Pragma("unroll") for (int _i = 0; _i < 2; ++_i) \
        __builtin_amdgcn_global_load_lds((const unsigned*)((gptr) + (voff)[_i]), (LAS unsigned*)(lds + (bufoff) + ldsw + _i * 8192), 16, 0, 0); } while (0)
#define G8_LDA(dst, b, h) do { _Pragma("unroll") for (int m = 0; m < 4; ++m) _Pragma("unroll") for (int k = 0; k < 2; ++k) dst[m][k] = *(const LAS bf16x8*)(lds + G8_SA(b, h) + aoff + m * 2048 + k * 1024); } while (0)
#define G8_LDB(dst, b, h) do { _Pragma("unroll") for (int n = 0; n < 2; ++n) _Pragma("unroll") for (int k = 0; k < 2; ++k) dst[n][k] = *(const LAS bf16x8*)(lds + G8_SB(b, h) + boff + n * 2048 + k * 1024); } while (0)
#define G8_MMA(ai, bj, At, Bq) do { __builtin_amdgcn_s_setprio(1); _Pragma("unroll") for (int m = 0; m < 4; ++m) _Pragma("unroll") for (int n = 0; n < 2; ++n) _Pragma("unroll") for (int k = 0; k < 2; ++k) \
        acc[ai][bj][m][n] = __builtin_amdgcn_mfma_f32_16x16x32_bf16(Bq[n][k], At[m][k], acc[ai][bj][m][n], 0, 0, 0); __builtin_amdgcn_s_setprio(0); } while (0)
#define G8_WAIT_V(n) asm volatile("s_waitcnt vmcnt(" #n ")" ::: "memory")
#define G8_WAIT_L(n) asm volatile("s_waitcnt lgkmcnt(" #n ")" ::: "memory")
#define G8_BAR __builtin_amdgcn_s_barrier()
#define G8_SCHED __builtin_amdgcn_sched_barrier(0)
    int pm, pn, npm = 0, npn = 0, ui = 0;
    if (!unit_at(0, gridDim.x, blockIdx.x, nM, nN, pm, pn)) return;
    f32x4 acc[2][2][4][2];
#pragma unroll
    for (int a = 0; a < 2; ++a)
#pragma unroll
        for (int b = 0; b < 2; ++b)
#pragma unroll
            for (int m = 0; m < 4; ++m)
#pragma unroll
                for (int n = 0; n < 2; ++n) acc[a][b][m][n] = (f32x4){0.f, 0.f, 0.f, 0.f};
    bf16x8 At[4][2], B0[2][2], B1[2][2];
    const size_t hA = (size_t)HALF * lda, hB = (size_t)HALF * K;
    const u16* cA = A + (size_t)pm * BM * lda;
    const u16* cB = Bt + (size_t)pn * BM * K;
    G8_STAGE(G8_SB(0, 0), cB, offB); G8_STAGE(G8_SB(0, 1), cB + hB, offB); G8_STAGE(G8_SA(0, 0), cA, offA); G8_STAGE(G8_SA(0, 1), cA + hA, offA);
    if (wr == 1) G8_BAR;
    G8_WAIT_V(2); G8_BAR;
    G8_STAGE(G8_SB(1, 0), cB + BK, offB); G8_STAGE(G8_SA(1, 0), cA + BK, offA); G8_STAGE(G8_SB(1, 1), cB + hB + BK, offB);
    G8_WAIT_V(6); G8_BAR;
    for (;;) {
        const bool has_next = unit_at(ui + 1, gridDim.x, blockIdx.x, nM, nN, npm, npn);
        const u16* nA = has_next ? A + (size_t)npm * BM * lda : cA;
        const u16* nB = has_next ? Bt + (size_t)npn * BM * K : cB;
        for (int t = 0; t < nt; t += 2) {
            const bool last = (t == nt - 2);
            const u16* a1 = cA + (size_t)(t + 1) * BK;
            const u16* a2 = last ? nA : cA + (size_t)(t + 2) * BK;
            const u16* b2 = last ? nB : cB + (size_t)(t + 2) * BK;
            const u16* a3 = a2 + BK; const u16* b3 = b2 + BK;
            G8_LDB(B0, 0, 0); G8_LDB(B1, 0, 1); G8_SCHED; G8_LDA(At, 0, 0); G8_STAGE(G8_SA(1, 1), a1 + hA, offA);
            G8_WAIT_V(8); G8_WAIT_L(0); G8_BAR; G8_MMA(0, 0, At, B0); G8_MMA(0, 1, At, B1); G8_BAR; G8_SCHED;
            G8_LDA(At, 0, 1); G8_STAGE(G8_SB(0, 0), b2, offB); G8_STAGE(G8_SB(0, 1), b2 + hB, offB); G8_STAGE(G8_SA(0, 0), a2, offA);
            G8_WAIT_V(8); G8_WAIT_L(0); G8_BAR; G8_MMA(1, 0, At, B0); G8_MMA(1, 1, At, B1); G8_BAR; G8_SCHED;
            G8_LDB(B0, 1, 0); G8_LDB(B1, 1, 1); G8_SCHED; G8_LDA(At, 1, 0); G8_STAGE(G8_SA(0, 1), a2 + hA, offA);
            G8_WAIT_V(8); G8_WAIT_L(0); G8_BAR; G8_MMA(0, 0, At, B0); G8_MMA(0, 1, At, B1); G8_BAR; G8_SCHED;
            G8_LDA(At, 1, 1); G8_STAGE(G8_SB(1, 0), b3, offB); G8_STAGE(G8_SB(1, 1), b3 + hB, offB); G8_STAGE(G8_SA(1, 0), a3, offA);
            G8_WAIT_V(8); G8_WAIT_L(0); G8_BAR; G8_MMA(1, 0, At, B0); G8_MMA(1, 1, At, B1); G8_BAR; G8_SCHED;
        }
        if (wr == 0) G8_BAR;
        E(acc, pm * BM, pn * BM, wr, wc, fr, fq);
        if (!has_next) break;
#pragma unroll
        for (int a = 0; a < 2; ++a)
#pragma unroll
            for (int b = 0; b < 2; ++b)
#pragma unroll
                for (int m = 0; m < 4; ++m)
#pragma unroll
                    for (int n = 0; n < 2; ++n) acc[a][b][m][n] = (f32x4){0.f, 0.f, 0.f, 0.f};
        pm = npm; pn = npn; cA = nA; cB = nB; ++ui;
        if (wr == 1) G8_BAR;
    }
    G8_WAIT_V(0);
    G8_BAR;
}
}

struct Ctx {
    Params p; unsigned char* ws; LAS unsigned char* lds; int tid, lane, wave, gtid, gthreads, gwave, gwaves;
};

__device__ __forceinline__ void wconv_tile(const Ctx& c, const float* src, int ldsrc, int Nsrc, int k0s, int n0s, const float* kgain, u16* dst, int lddst, int n0d, int k0d) {
    LAS float* T = (LAS float*)c.lds;
    const int tid = c.tid;
    {
        const int k = tid >> 3, n8 = (tid & 7) * 8;
        f32x4 a = {0.f, 0.f, 0.f, 0.f}, b = {0.f, 0.f, 0.f, 0.f};
        if (src != nullptr && n0s + n8 < Nsrc) {
            const float* sp = src + (size_t)(k0s + k) * ldsrc + n0s + n8;
            a = *(const f32x4*)sp; b = *(const f32x4*)(sp + 4);
            if (kgain) { const float g = kgain[k0s + k]; a = a * g; b = b * g; }
        }
        LAS float* tp = T + k * 65 + n8;
        tp[0] = a[0]; tp[1] = a[1]; tp[2] = a[2]; tp[3] = a[3]; tp[4] = b[0]; tp[5] = b[1]; tp[6] = b[2]; tp[7] = b[3];
    }
    __syncthreads();
    {
        const int n = tid >> 3, k8 = (tid & 7) * 8;
        const LAS float* tp = T + k8 * 65 + n;
        u32x4 w;
        w.x = cvt_pk_bf16(tp[0], tp[65]); w.y = cvt_pk_bf16(tp[130], tp[195]); w.z = cvt_pk_bf16(tp[260], tp[325]); w.w = cvt_pk_bf16(tp[390], tp[455]);
        *(u32x4*)(dst + (size_t)(n0d + n) * lddst + k0d + k8) = w;
    }
    __syncthreads();
}

__device__ __forceinline__ void phase_wconv(const Ctx& c, int l) {
    u16* bt_in = (u16*)(c.ws + WS_BT_IN); u16* bt_mla = (u16*)(c.ws + WS_BT_MLA); u16* bt_out = (u16*)(c.ws + WS_BT_OUT);
    u16* bt_up = (u16*)(c.ws + WS_BT_UP); u16* bt_dn = (u16*)(c.ws + WS_BT_DN);
    const float* w_in = c.p.in[I_WIN] + (size_t)l * 1024 * INW;
    const float* wqb = c.p.in[I_WQB] + (size_t)l * 256 * 384;
    const float* wkvb = c.p.in[I_WKVB] + (size_t)l * 128 * 512;
    const float* w_out = c.p.in[I_WOUT] + (size_t)l * 1024 * 1024;
    const float* w_up = c.p.in[I_WUP] + (size_t)l * 1024 * 5632;
    const float* w_dn = c.p.in[I_WDOWN] + (size_t)l * DFF * 1024;
    constexpr int T_IN = 40 * 16, T_MLA = 16 * 8, T_OUT = 16 * 16, T_UP = 88 * 16, T_DN = 16 * 44;
    constexpr int T_ALL = T_IN + T_MLA + T_OUT + T_UP + T_DN;
    for (int it = blockIdx.x; it < T_ALL; it += gridDim.x) {
        int r = it;
        if (r < T_IN) { const int nt = r / 16, kt = r % 16; wconv_tile(c, w_in, INW, INW, kt * 64, nt * 64, nullptr, bt_in, 1024, nt * 64, kt * 64); continue; }
        r -= T_IN;
        if (r < T_MLA) {
            const int nt = r / 8, kt = r % 8;
            if (nt < 6 && kt < 4) wconv_tile(c, wqb, 384, 384, kt * 64, nt * 64, c.p.in[I_CQAG] + l * 256, bt_mla, 512, nt * 64, kt * 64);
            else if (nt >= 6 && nt < 14 && kt >= 4 && kt < 6) wconv_tile(c, wkvb, 512, 512, (kt - 4) * 64, (nt - 6) * 64, c.p.in[I_CKVAG] + l * 128, bt_mla, 512, nt * 64, kt * 64);
            else wconv_tile(c, nullptr, 0, 0, 0, 0, nullptr, bt_mla, 512, nt * 64, kt * 64);
            continue;
        }
        r -= T_MLA;
        if (r < T_OUT) { const int nt = r / 16, kt = r % 16; wconv_tile(c, w_out, 1024, 1024, kt * 64, nt * 64, nullptr, bt_out, 1024, nt * 64, kt * 64); continue; }
        r -= T_OUT;
        if (r < T_UP) { const int nt = r / 16, kt = r % 16, pn = nt >> 2, q = nt & 3;
            const int n0s = q < 2 ? 128 * pn + 64 * q : DFF + 128 * pn + 64 * (q - 2);
            wconv_tile(c, w_up, 5632, 5632, kt * 64, n0s, nullptr, bt_up, 1024, nt * 64, kt * 64); continue; }
        r -= T_UP;
        { const int nt = r / 44, kt = r % 44; wconv_tile(c, w_dn, 1024, 1024, kt * 64, nt * 64, nullptr, bt_dn, DFF, nt * 64, kt * 64); }
    }
}

__device__ __forceinline__ void phase_rope_table(const Ctx& c) {
    float2* tab = (float2*)(c.ws + WS_ROPE);
    for (int i = c.gtid; i < 4096 * 16; i += c.gthreads) {
        const int pos = i >> 4, fi = i & 15;
        const int f4 = fi & 3, f10 = fi >> 2;
        const float fb = f4 == 0 ? 1.0f : (f4 == 1 ? 0.5623413251903491f : (f4 == 2 ? 0.31622776601683794f : 0.1778279410038923f));
        const float fm = f10 == 0 ? 1.0f : (f10 == 1 ? 0.1f : (f10 == 2 ? 0.01f : 0.001f));
        const float f = fb * fm;
        const float ang = (float)pos * f;
        const double rev = (double)ang * 0.15915494309189535;
        const float fr = (float)(rev - rint(rev));
        tab[i] = make_float2(__builtin_amdgcn_cosf(fr), __builtin_amdgcn_sinf(fr));
    }
}

__device__ __forceinline__ void phase_rmsnorm(const Ctx& c, const float* x, const float* g, u16* xn) {
    f32x4 gv[4];
#pragma unroll
    for (int j = 0; j < 4; ++j) gv[j] = *(const f32x4*)(g + (j * 64 + c.lane) * 4);
    for (int row = c.gwave; row < NTOK; row += 2 * c.gwaves) {
        const int row2 = row + c.gwaves; const bool has2 = row2 < NTOK;
        const f32x4* xr = (const f32x4*)(x + (size_t)row * 1024) + c.lane;
        const f32x4* xr2 = (const f32x4*)(x + (size_t)(has2 ? row2 : row) * 1024) + c.lane;
        f32x4 v[4], v2[4]; float s = 0.f, s2 = 0.f;
#pragma unroll
        for (int j = 0; j < 4; ++j) { v[j] = xr[64 * j]; v2[j] = xr2[64 * j]; }
#pragma unroll
        for (int j = 0; j < 4; ++j) { s += (v[j][0] * v[j][0] + v[j][1] * v[j][1]) + (v[j][2] * v[j][2] + v[j][3] * v[j][3]); s2 += (v2[j][0] * v2[j][0] + v2[j][1] * v2[j][1]) + (v2[j][2] * v2[j][2] + v2[j][3] * v2[j][3]); }
        const float rs = rsqrtf(wave_sum(s) * (1.f / 1024.f) + EPS), rs2 = rsqrtf(wave_sum(s2) * (1.f / 1024.f) + EPS);
        u32x2* o = (u32x2*)(xn + (size_t)row * 1024) + c.lane;
#pragma unroll
        for (int j = 0; j < 4; ++j) { u32x2 w; w.x = cvt_pk_bf16(v[j][0] * rs * gv[j][0], v[j][1] * rs * gv[j][1]); w.y = cvt_pk_bf16(v[j][2] * rs * gv[j][2], v[j][3] * rs * gv[j][3]); o[64 * j] = w; }
        if (has2) { u32x2* o2 = (u32x2*)(xn + (size_t)row2 * 1024) + c.lane;
#pragma unroll
            for (int j = 0; j < 4; ++j) { u32x2 w; w.x = cvt_pk_bf16(v2[j][0] * rs2 * gv[j][0], v2[j][1] * rs2 * gv[j][1]); w.y = cvt_pk_bf16(v2[j][2] * rs2 * gv[j][2], v2[j][3] * rs2 * gv[j][3]); o2[64 * j] = w; } }
    }
}

template <int MODE, bool ROPE>
__device__ __forceinline__ void pp_vec64(const u16* src, u16* dst, const float* gain, int s, float prescale, const float2* tab) {
    float r1, r2;
    if (MODE == 0) { r1 = rsqrtf(sumsq_bf16<8>(src) * (1.f / 64.f) + EPS) * prescale; r2 = r1; }
    else { r1 = rsqrtf(sumsq_bf16<4>(src) * (1.f / 32.f) + EPS) * prescale; r2 = rsqrtf(sumsq_bf16<4>(src + 32) * (1.f / 32.f) + EPS) * prescale; }
#pragma unroll
    for (int hf = 0; hf < 2; ++hf) {
        float v[32]; load_bf16_vec<4>(src + 32 * hf, v);
        const float rr = hf == 0 ? r1 : r2;
        const float* gp = gain + (MODE == 0 ? 32 * hf : 0);
#pragma unroll
        for (int i = 0; i < 32; ++i) v[i] = v[i] * rr * gp[i];
        if (ROPE) {
            const float2* t = tab + (hf == 0 ? (s >> 6) : (s & 63)) * 16;
#pragma unroll
            for (int i = 0; i < 16; ++i) { const float2 a = t[i]; const float x1 = v[i], x2 = v[16 + i]; v[i] = x1 * a.x - x2 * a.y; v[16 + i] = x1 * a.y + x2 * a.x; }
        }
        store_bf16_vec<4>(dst + 32 * hf, v);
    }
}
template <int NA>
__device__ __forceinline__ void pp_vec96(const u16* srcA, float rsA, const u16* srcB, u16* dst, const float* gain, int s, float prescale, const float2* tab) {
    float ss = sumsq_bf16<NA / 8>(srcA) * rsA * rsA;
    if (NA < 96) ss += sumsq_bf16<(96 - NA) / 8>(srcB);
    const float rn = rsqrtf(ss * (1.f / 96.f) + EPS) * prescale;
    const float ra = rn * rsA;
#pragma unroll 2
    for (int cch = 0; cch < 8; ++cch) {
        float v[8]; load_bf16_vec<1>(srcA + 8 * cch, v);
#pragma unroll
        for (int i = 0; i < 8; ++i) v[i] = v[i] * ra * gain[8 * cch + i];
        store_bf16_vec<1>(dst + 8 * cch, v);
    }
    float v[32];
    if (NA == 96) { load_bf16_vec<4>(srcA + 64, v);
#pragma unroll
        for (int i = 0; i < 32; ++i) v[i] = v[i] * ra * gain[64 + i]; }
    else { load_bf16_vec<4>(srcB, v);
#pragma unroll
        for (int i = 0; i < 32; ++i) v[i] = v[i] * rn * gain[64 + i]; }
    const float2* t = tab + s * 16;
#pragma unroll
    for (int i = 0; i < 16; ++i) { const float2 a = t[i]; const float x1 = v[i], x2 = v[16 + i]; v[i] = x1 * a.x - x2 * a.y; v[16 + i] = x1 * a.y + x2 * a.x; }
    store_bf16_vec<4>(dst + 64, v);
}

__device__ __forceinline__ void vtrans_tile4(const Ctx& c, const u16* src, int ldsrc, size_t tok0, int tstride, const u16* rs_src  , u16* dst  ) {
    LAS unsigned char* T = c.lds;
    LAS float* RS = (LAS float*)(c.lds + 32768);
    const int tid = c.tid;
    u32x4 w[4];
#pragma unroll
    for (int i = 0; i < 4; ++i) { const int p = i * 64 + (tid >> 3), cc = tid & 7; w[i] = *(const u32x4*)(src + (tok0 + (size_t)p * tstride) * ldsrc + cc * 8); }
    if (rs_src) {
        const int p = tid >> 1, part = tid & 1;
        float s = sumsq_bf16<8>(rs_src + (tok0 + (size_t)p * tstride) * INWP + 1536 + part * 64);
        s += __shfl_xor(s, 1);
        if (part == 0) RS[p] = rsqrtf(s * (1.f / 128.f) + EPS);
        __syncthreads();
#pragma unroll
        for (int i = 0; i < 4; ++i) { const float r = RS[i * 64 + (tid >> 3)];
            w[i].x = cvt_pk_bf16(bf_lo(w[i].x) * r, bf_hi(w[i].x) * r); w[i].y = cvt_pk_bf16(bf_lo(w[i].y) * r, bf_hi(w[i].y) * r);
            w[i].z = cvt_pk_bf16(bf_lo(w[i].z) * r, bf_hi(w[i].z) * r); w[i].w = cvt_pk_bf16(bf_lo(w[i].w) * r, bf_hi(w[i].w) * r); }
    }
#pragma unroll
    for (int i = 0; i < 4; ++i) { const int p = i * 64 + (tid >> 3), cc = tid & 7; *(LAS u32x4*)(T + p * 128 + ((cc ^ ((p >> 3) & 7)) * 16)) = w[i]; }
    __syncthreads();
#pragma unroll
    for (int i = 0; i < 4; ++i) {
        const int d = tid >> 3, pc = (tid & 7) + 8 * i;
        const LAS unsigned char* tp = T + (8 * pc) * 128 + (((d >> 3) ^ (pc & 7)) * 16) + (d & 7) * 2;
        unsigned e[8];
#pragma unroll
        for (int j = 0; j < 8; ++j) e[j] = *(const LAS u16*)(tp + j * 128);
        u32x4 o; o.x = e[0] | (e[1] << 16); o.y = e[2] | (e[3] << 16); o.z = e[4] | (e[5] << 16); o.w = e[6] | (e[7] << 16);
        *(u32x4*)(dst + (size_t)d * 4096 + pc * 8) = o;
    }
    __syncthreads();
}

__device__ __forceinline__ void phase_pp(const Ctx& c, int l) {
    const u16* proj = (const u16*)(c.ws + WS_R1);
    const u16* cbuf = (const u16*)(c.ws + WS_XN);
    const float2* tab = (const float2*)(c.ws + WS_ROPE);
    const float sA = 0.125f * LOG2E, sB = 0.17677669529663687f * LOG2E, sC = 0.10206207261596575f * LOG2E;
    { u16* Kp = (u16*)(c.ws + WS_KA); const float* g = c.p.in[I_AKN] + l * 64;
      for (int j = c.gtid; j < NTOK * 2; j += c.gthreads) { const int T = j >> 1, hh = j & 1, b = T >> 12, s = T & 4095;
        pp_vec64<0, true>(proj + (size_t)T * INWP + 256 + hh * 64, Kp + ((size_t)(b * 2 + hh) * 4096 + s) * 64, g, s, 1.f, tab); } }
    { u16* Kp = (u16*)(c.ws + WS_KB); const float* g = c.p.in[I_BKN] + l * 32;
      for (int j = c.gtid; j < NTOK * 4; j += c.gthreads) { const int T = j >> 2, hh = j & 3, b = T >> 12, s = T & 4095;
        pp_vec64<1, false>(proj + (size_t)T * INWP + 768 + hh * 64, Kp + ((size_t)(b * 4 + hh) * 4096 + s) * 64, g, s, 1.f, tab); } }
    { u16* Kp = (u16*)(c.ws + WS_KD); const float* g = c.p.in[I_DKN] + l * 64;
      for (int j = c.gtid; j < NTOK * 4; j += c.gthreads) { const int T = j >> 2, hh = j & 3, b = T >> 12, s = T & 4095;
        pp_vec64<0, false>(proj + (size_t)T * INWP + 1952 + hh * 64, Kp + ((size_t)(b * 4 + hh) * 4096 + s) * 64, g, s, 1.f, tab); } }
    { u16* Q = (u16*)(c.ws + WS_QC); const float* g = c.p.in[I_CQN] + l * 96;
      for (int j = c.gtid; j < NTOK * 4; j += c.gthreads) { const int T = j >> 2, hh = j & 3, b = T >> 12, s = T & 4095;
        float ssl = sumsq_bf16<8>(proj + (size_t)T * INWP + 1280 + hh * 64);
        ssl += __shfl_xor(ssl, 1); ssl += __shfl_xor(ssl, 2);
        const float rs = rsqrtf(ssl * (1.f / 256.f) + EPS);
        pp_vec96<96>(cbuf + (size_t)T * 1024 + hh * 96, rs, nullptr, Q + ((size_t)(b * 4 + hh) * 4096 + s) * 96, g, s, sC, tab); } }
    { u16* Kp = (u16*)(c.ws + WS_KC); const float* g = c.p.in[I_CKN] + l * 96;
      for (int j = c.gtid; j < NTOK * 4; j += c.gthreads) { const int T = j >> 2, hh = j & 3, b = T >> 12, s = T & 4095;
        float ssl = sumsq_bf16<4>(proj + (size_t)T * INWP + 1536 + hh * 32);
        ssl += __shfl_xor(ssl, 1); ssl += __shfl_xor(ssl, 2);
        const float rs = rsqrtf(ssl * (1.f / 128.f) + EPS);
        pp_vec96<64>(cbuf + (size_t)T * 1024 + 384 + hh * 128, rs, proj + (size_t)T * INWP + 1664, Kp + ((size_t)(b * 4 + hh) * 4096 + s) * 96, g, s, 1.f, tab); } }
    for (int j = blockIdx.x; j < 22 * 8 * 16; j += gridDim.x) {
        const int tile = j & 15, b = (j >> 4) & 7, kind = j >> 7;
        const size_t tb = (size_t)b * 4096;
        const int p0 = tile * 256;
        if (kind < 2) { const int hh = kind; vtrans_tile4(c, proj + 384 + hh * 64, INWP, tb + p0, 1, nullptr, (u16*)(c.ws + WS_VTA) + (size_t)(b * 2 + hh) * 64 * 4096 + p0); }
        else if (kind < 6) { const int hh = kind - 2; vtrans_tile4(c, proj + 1024 + hh * 64, INWP, tb + p0, 1, nullptr, (u16*)(c.ws + WS_VTB) + (size_t)(b * 4 + hh) * 64 * 4096 + p0); }
        else if (kind < 10) { const int hh = kind - 6; vtrans_tile4(c, cbuf + 384 + hh * 128 + 64, 1024, tb + p0, 1, proj, (u16*)(c.ws + WS_VTC) + (size_t)(b * 4 + hh) * 64 * 4096 + p0); }
        else { const int k2 = kind - 10, br = k2 >> 2, hh = k2 & 3; const int dil = br == 0 ? 1 : (br == 1 ? 4 : 16), L = 4096 / dil;
               const int r = p0 / L, j0 = p0 % L;
               vtrans_tile4(c, proj + 2208 + hh * 64, INWP, tb + (size_t)j0 * dil + r, dil, nullptr, (u16*)(c.ws + WS_VTD) + (size_t)((br * 8 + b) * 4 + hh) * 64 * 4096 + p0); }
    }
}

#define AT_BAR() do { asm volatile("s_waitcnt lgkmcnt(0)" ::: "memory"); __builtin_amdgcn_s_barrier(); asm volatile("" ::: "memory"); } while (0)
template <int TYPE>
__device__ __forceinline__ void attn_unit(const Ctx& c, int l, int b, int hh, int qb, int br) {
    constexpr int DQK = TYPE == 2 ? 96 : 64;
    constexpr int CPR = DQK / 8;
    constexpr int KROWB = DQK * 2 + 16;
    constexpr int KTB = 64 * KROWB;
    constexpr int VROWB = 144;
    constexpr int BUFB = KTB + 64 * VROWB;
    constexpr int NPASS = TYPE == 1 ? 2 : 1;
    constexpr int NKK = TYPE == 1 ? 2 : DQK / 16;
    constexpr bool PIPE = TYPE != 1;
    LAS unsigned char* lds = c.lds;
    int tid_ = c.tid; asm volatile("" : "+v"(tid_));
    asm volatile("" : "+s"(l), "+s"(b), "+s"(hh), "+s"(qb), "+s"(br));
    const int tid = tid_, lane = tid & 63, w = __builtin_amdgcn_readfirstlane(tid >> 6), q31 = lane & 31, h = lane >> 5;
    int dil = 1, r = 0, L = 4096, j0 = qb * 256;
    if (TYPE == 3) { dil = br == 0 ? 1 : (br == 1 ? 4 : 16); L = 4096 / dil; const int P0 = qb * 256; r = P0 / L; j0 = P0 % L; }
    const u16 *Qg, *Kg, *Vg;
    const float *gq, *gk; int ng;
    if (TYPE == 0) { Qg = (const u16*)(c.ws + WS_QA) + (size_t)(b * 4 + hh) * 4096 * 64; Kg = (const u16*)(c.ws + WS_KA) + (size_t)(b * 2 + (hh >> 1)) * 4096 * 64;
                     Vg = (const u16*)(c.ws + WS_VTA) + (size_t)(b * 2 + (hh >> 1)) * 64 * 4096; gq = c.p.in[I_AQN] + l * 64; gk = c.p.in[I_AKN] + l * 64; ng = 64; }
    else if (TYPE == 1) { Qg = (const u16*)(c.ws + WS_QB) + (size_t)(b * 4 + hh) * 4096 * 64; Kg = (const u16*)(c.ws + WS_KB) + (size_t)(b * 4 + hh) * 4096 * 64;
                     Vg = (const u16*)(c.ws + WS_VTB) + (size_t)(b * 4 + hh) * 64 * 4096; gq = c.p.in[I_BQN] + l * 32; gk = c.p.in[I_BKN] + l * 32; ng = 32; }
    else if (TYPE == 2) { Qg = (const u16*)(c.ws + WS_QC) + (size_t)(b * 4 + hh) * 4096 * 96; Kg = (const u16*)(c.ws + WS_KC) + (size_t)(b * 4 + hh) * 4096 * 96;
                     Vg = (const u16*)(c.ws + WS_VTC) + (size_t)(b * 4 + hh) * 64 * 4096; gq = c.p.in[I_CQN] + l * 96; gk = c.p.in[I_CKN] + l * 96; ng = 96; }
    else { Qg = (const u16*)(c.ws + WS_QD) + (size_t)(b * 4 + hh) * 4096 * 64; Kg = (const u16*)(c.ws + WS_KD) + (size_t)(b * 4 + hh) * 4096 * 64;
                     Vg = (const u16*)(c.ws + WS_VTD) + (size_t)((br * 8 + b) * 4 + hh) * 64 * 4096 + (size_t)r * L; gq = c.p.in[I_DQN] + l * 64; gk = c.p.in[I_DKN] + l * 64; ng = 64; }
    const float scale = TYPE == 1 ? 0.17677669529663687f : (TYPE == 2 ? 0.10206207261596575f : 0.125f);
    const float Mp = (float)ng * wave_absmax(gq, ng, lane) * wave_absmax(gk, ng, lane) * scale * LOG2E * 1.02f;
    float sl = 0.f;
    if (TYPE == 1) sl = exp2f(-(float)(hh + 1)) * LOG2E;
    if (TYPE == 3) sl = exp2f(-(float)(hh + 5)) * LOG2E * (float)dil;
    int klo = 0, khi = L;
    if (TYPE == 1) { const int W = (int)((2.f * Mp + 50.f) / sl) + 1; klo = j0 - W; khi = j0 + 256 + W; klo = klo < 0 ? 0 : (klo & ~63); khi = khi > L ? L : ((khi + 63) & ~63); }
    if (TYPE == 3) { klo = j0 - 64; khi = j0 + 320; klo = klo < 0 ? 0 : klo; khi = khi > L ? L : khi; }
    const int ntile = (khi - klo) >> 6;
    const int jq = j0 + 32 * w + q31;
    const int pi = (q31 & ~12) | ((q31 & 4) << 1) | ((q31 & 8) >> 1);
    const int vfo = q31 * VROWB + h * 16;
    const int krow0 = tid / CPR, kcc0 = tid % CPR, krow1 = (tid + 512) / CPR, kcc1 = (tid + 512) % CPR;
    const int vd = tid >> 3, vcc = tid & 7;
    f32x16 O[2], Osv[2];
    float lsum = 0.f;
#pragma unroll
    for (int d = 0; d < 2; ++d)
#pragma unroll
        for (int i = 0; i < 16; ++i) Osv[d][i] = 0.f;
#pragma unroll 1
    for (int pass = 0; pass < NPASS; ++pass) {
        const int kfo = pi * KROWB + h * 16 + pass * 64;
        bf16x8 qf[NKK];
        if (TYPE == 2) {
            const u16* qrow = Qg + ((size_t)jq * dil + r) * DQK + h * 8 + pass * 32;
#pragma unroll
            for (int kk = 0; kk < NKK; ++kk) qf[kk] = *(const bf16x8*)(qrow + kk * 16);
        } else {
            const int sq_ = jq * dil + r;
            const u16* qraw = (const u16*)(c.ws + WS_R1) + ((size_t)b * 4096 + sq_) * INWP + (TYPE == 0 ? 0 : (TYPE == 1 ? 512 : 1696)) + hh * 64 + h * 8 + pass * 32;
            float qv[NKK][8];
            float ssq = 0.f;
#pragma unroll
            for (int kk = 0; kk < NKK; ++kk) { load_bf16_vec<1>(qraw + kk * 16, qv[kk]);
#pragma unroll
                for (int j = 0; j < 8; ++j) ssq += qv[kk][j] * qv[kk][j]; }
            ssq += __shfl_xor(ssq, 32);
            const float rnq = rsqrtf(ssq * (1.f / (float)(16 * NKK)) + EPS) * (scale * LOG2E);
#pragma unroll
            for (int kk = 0; kk < NKK; ++kk) { const f32x4 g0 = *(const f32x4*)(gq + kk * 16 + h * 8), g1 = *(const f32x4*)(gq + kk * 16 + h * 8 + 4);
#pragma unroll
                for (int j = 0; j < 4; ++j) { qv[kk][j] *= rnq * g0[j]; qv[kk][4 + j] *= rnq * g1[j]; } }
            if (TYPE == 0) {
                const float2* tab = (const float2*)(c.ws + WS_ROPE);
#pragma unroll
                for (int hf = 0; hf < 2; ++hf) {
                    const float2* t = tab + (hf == 0 ? (sq_ >> 6) : (sq_ & 63)) * 16 + h * 8;
#pragma unroll
                    for (int j = 0; j < 8; ++j) { const float2 a = t[j]; const float x1 = qv[NKK >= 4 ? 2 * hf : 0][j], x2 = qv[NKK >= 4 ? 2 * hf + 1 : 1][j];
                        qv[NKK >= 4 ? 2 * hf : 0][j] = x1 * a.x - x2 * a.y; qv[NKK >= 4 ? 2 * hf + 1 : 1][j] = x1 * a.y + x2 * a.x; }
                }
            }
#pragma unroll
            for (int kk = 0; kk < NKK; ++kk) { u32x4 pw;
                pw.x = cvt_pk_bf16(qv[kk][0], qv[kk][1]); pw.y = cvt_pk_bf16(qv[kk][2], qv[kk][3]); pw.z = cvt_pk_bf16(qv[kk][4], qv[kk][5]); pw.w = cvt_pk_bf16(qv[kk][6], qv[kk][7]);
                qf[kk] = __builtin_bit_cast(bf16x8, pw); }
        }
        lsum = 0.f;
#pragma unroll
        for (int d = 0; d < 2; ++d)
#pragma unroll
            for (int i = 0; i < 16; ++i) O[d][i] = 0.f;
        constexpr int VB0 = 2 * KTB;
        u32x4 kr0, kr1 = {0u, 0u, 0u, 0u}, vr;
#define AT_GLOADK(kp0) do { kr0 = *(const u32x4*)(Kg + ((size_t)((kp0) + krow0) * dil + r) * DQK + kcc0 * 8); \
        if (DQK == 96 && tid < 256) kr1 = *(const u32x4*)(Kg + ((size_t)((kp0) + krow1) * dil + r) * DQK + kcc1 * 8); } while (0)
#define AT_GLOADV(kp0) do { vr = *(const u32x4*)(Vg + (size_t)vd * 4096 + (kp0) + vcc * 8); } while (0)
#define AT_LWRITEK(buf) do { *(LAS u32x4*)(lds + (buf) * KTB + krow0 * KROWB + kcc0 * 16) = kr0; \
        if (DQK == 96 && tid < 256) *(LAS u32x4*)(lds + (buf) * KTB + krow1 * KROWB + kcc1 * 16) = kr1; } while (0)
#define AT_LWRITEV(buf) do { *(LAS u32x4*)(lds + VB0 + (buf) * 64 * VROWB + vd * VROWB + vcc * 16) = vr; } while (0)
#define AT_QK(Sx, kbuf_, kp0_) do { \
        _Pragma("unroll") for (int kb = 0; kb < 2; ++kb) { \
            if (TYPE == 1 || TYPE == 3) { \
                const float tq = (float)(jq - (kp0_) - 8 * h - kb * 32); \
                _Pragma("unroll") for (int i = 0; i < 16; ++i) { \
                    const float dd = fabsf(tq - (float)(16 * (i >> 3) + (i & 7))); \
                    float v_ = -Mp - sl * dd; \
                    if (TYPE == 3) v_ = dd <= 64.f ? v_ : -INFINITY; \
                    Sx[kb][i] = v_; } \
            } else { _Pragma("unroll") for (int i = 0; i < 16; ++i) Sx[kb][i] = -Mp; } } \
        _Pragma("unroll") for (int kk = 0; kk < NKK; ++kk) \
            _Pragma("unroll") for (int kb = 0; kb < 2; ++kb) {     \
                const bf16x8 kf = *(const LAS bf16x8*)(lds + (kbuf_) * KTB + kfo + kb * 32 * KROWB + kk * 32); \
                Sx[kb] = __builtin_amdgcn_mfma_f32_32x32x16_bf16(kf, qf[kk], Sx[kb], 0, 0, 0); } } while (0)
        f32x16 S[2][2];
        const int jw = j0 + 32 * w;
#define AT_ACTIVE(kp0_) (TYPE != 3 || (((kp0_) + 63 >= jw - 64) && ((kp0_) <= jw + 31 + 64)))
        AT_GLOADK(klo); AT_GLOADV(klo); AT_LWRITEK(0); AT_LWRITEV(0);
        if (PIPE && ntile > 1) { AT_GLOADK(klo + 64); AT_LWRITEK(1); }
        AT_BAR();
        if (PIPE) { if (AT_ACTIVE(klo)) AT_QK(S[0], 0, klo);
                    AT_BAR(); }
        for (int t0 = 0; t0 < ntile; t0 += 2) {
#pragma unroll
          for (int half = 0; half < 2; ++half) {
            const int t = t0 + half;
            if (t < ntile) {
            const int kp0 = klo + t * 64;
            if (PIPE ? t + 2 < ntile : t + 1 < ntile) AT_GLOADK(kp0 + (PIPE ? 128 : 64));
            if (t + 1 < ntile) AT_GLOADV(kp0 + 64);
            if (PIPE) { if (t + 1 < ntile && AT_ACTIVE(kp0 + 64)) AT_QK(S[half ^ 1], half ^ 1, kp0 + 64); }
            if (AT_ACTIVE(kp0)) {
                if (!PIPE) AT_QK(S[half], half, kp0);
                bf16x8 pf[4];
#pragma unroll
                for (int kb = 0; kb < 2; ++kb) {
                    float ps = 0.f;
                    float pe[16];
#pragma unroll
                    for (int i = 0; i < 16; ++i) { pe[i] = __builtin_amdgcn_exp2f(S[half][kb][i]); ps += pe[i]; }
                    lsum += ps;
#pragma unroll
                    for (int s2 = 0; s2 < 2; ++s2) {
                        u32x4 pw;
                        pw.x = cvt_pk_bf16(pe[8 * s2 + 0], pe[8 * s2 + 1]); pw.y = cvt_pk_bf16(pe[8 * s2 + 2], pe[8 * s2 + 3]);
                        pw.z = cvt_pk_bf16(pe[8 * s2 + 4], pe[8 * s2 + 5]); pw.w = cvt_pk_bf16(pe[8 * s2 + 6], pe[8 * s2 + 7]);
                        pf[kb * 2 + s2] = __builtin_bit_cast(bf16x8, pw);
                    }
                }
#pragma unroll
                for (int ks = 0; ks < 4; ++ks)
#pragma unroll
                    for (int db = 0; db < 2; ++db) {
                        const bf16x8 vf = *(const LAS bf16x8*)(lds + VB0 + half * 64 * VROWB + vfo + db * 32 * VROWB + ks * 32);
                        O[db] = __builtin_amdgcn_mfma_f32_32x32x16_bf16(vf, pf[ks], O[db], 0, 0, 0);
                    }
            }
            if (PIPE ? t + 2 < ntile : t + 1 < ntile) AT_LWRITEK(PIPE ? half : half ^ 1);
            if (t + 1 < ntile) AT_LWRITEV(half ^ 1);
            AT_BAR();
            }
          }
        }
#undef AT_GLOADK
#undef AT_GLOADV
#undef AT_LWRITEK
#undef AT_LWRITEV
#undef AT_QK
#undef AT_ACTIVE
        if (TYPE == 1 && pass == 0) {
            const float i1 = 1.f / (lsum + __shfl_xor(lsum, 32));
#pragma unroll
            for (int d = 0; d < 2; ++d)
#pragma unroll
                for (int i = 0; i < 16; ++i) Osv[d][i] = O[d][i] * i1;
        }
    }
    const int sq = jq * dil + r;
    const size_t tok = (size_t)b * 4096 + sq;
    const float lt = lsum + __shfl_xor(lsum, 32);
    if (TYPE == 0 || TYPE == 2) {
        const float inv = 1.f / lt;
        u16* op = (u16*)(c.ws + WS_MIX) + tok * 1024 + (TYPE == 0 ? 0 : 512) + hh * 64;
#pragma unroll
        for (int db = 0; db < 2; ++db)
#pragma unroll
            for (int gp = 0; gp < 2; ++gp) {
                u32x2 ev, od;
                ev.x = cvt_pk_bf16(O[db][8 * gp + 0] * inv, O[db][8 * gp + 1] * inv); ev.y = cvt_pk_bf16(O[db][8 * gp + 2] * inv, O[db][8 * gp + 3] * inv);
                od.x = cvt_pk_bf16(O[db][8 * gp + 4] * inv, O[db][8 * gp + 5] * inv); od.y = cvt_pk_bf16(O[db][8 * gp + 6] * inv, O[db][8 * gp + 7] * inv);
                const unsigned sx = h ? ev.x : od.x, sy = h ? ev.y : od.y;
                const unsigned rx = (unsigned)__shfl_xor((int)sx, 32), ry = (unsigned)__shfl_xor((int)sy, 32);
                u32x4 w4;
                if (h) { w4.x = rx; w4.y = ry; w4.z = od.x; w4.w = od.y; } else { w4.x = ev.x; w4.y = ev.y; w4.z = rx; w4.w = ry; }
                *(u32x4*)(op + db * 32 + 16 * gp + 8 * h) = w4;
            }
    } else if (TYPE == 1) {
        float pr = lane < 32 ? c.p.in[I_LQ1][l * 32 + lane] * c.p.in[I_LK1][l * 32 + lane] : c.p.in[I_LQ2][l * 32 + lane - 32] * c.p.in[I_LK2][l * 32 + lane - 32];
#pragma unroll
        for (int o = 1; o < 32; o <<= 1) pr += __shfl_xor(pr, o);
        const float s1 = __shfl(pr, 0), s2 = __shfl(pr, 32);
        const float lam_init = 0.8f - 0.6f * expf(-0.3f * (float)l);
        const float lam = expf(s1) - expf(s2) + lam_init;
        const float i2 = lam / lt;
        float ss = 0.f;
#pragma unroll
        for (int db = 0; db < 2; ++db)
#pragma unroll
            for (int i = 0; i < 16; ++i) { const float o = Osv[db][i] - O[db][i] * i2; O[db][i] = o; ss += o * o; }
        ss += __shfl_xor(ss, 32);
        const float rn = rsqrtf(ss * (1.f / 64.f) + EPS) * (1.f - lam_init);
        const float* gs = c.p.in[I_BSUB] + l * 64 + 4 * h;
        u16* op = (u16*)(c.ws + WS_MIX) + tok * 1024 + 256 + hh * 64 + 4 * h;
#pragma unroll
        for (int db = 0; db < 2; ++db)
#pragma unroll
            for (int g = 0; g < 4; ++g) {
                const f32x4 gv = *(const f32x4*)(gs + db * 32 + 8 * g);
                u32x2 wv; wv.x = cvt_pk_bf16(O[db][4 * g] * rn * gv[0], O[db][4 * g + 1] * rn * gv[1]); wv.y = cvt_pk_bf16(O[db][4 * g + 2] * rn * gv[2], O[db][4 * g + 3] * rn * gv[3]);
                *(u32x2*)(op + db * 32 + 8 * g) = wv;
            }
    } else {
        const float inv = 1.f / lt;
        u16* op = (u16*)(c.ws + dpart_off(br)) + tok * 256 + hh * 64;
#pragma unroll
        for (int db = 0; db < 2; ++db)
#pragma unroll
            for (int gp = 0; gp < 2; ++gp) {
                u32x2 ev, od;
                ev.x = cvt_pk_bf16(O[db][8 * gp + 0] * inv, O[db][8 * gp + 1] * inv); ev.y = cvt_pk_bf16(O[db][8 * gp + 2] * inv, O[db][8 * gp + 3] * inv);
                od.x = cvt_pk_bf16(O[db][8 * gp + 4] * inv, O[db][8 * gp + 5] * inv); od.y = cvt_pk_bf16(O[db][8 * gp + 6] * inv, O[db][8 * gp + 7] * inv);
                const unsigned sx = h ? ev.x : od.x, sy = h ? ev.y : od.y;
                const unsigned rx = (unsigned)__shfl_xor((int)sx, 32), ry = (unsigned)__shfl_xor((int)sy, 32);
                u32x4 w4;
                if (h) { w4.x = rx; w4.y = ry; w4.z = od.x; w4.w = od.y; } else { w4.x = ev.x; w4.y = ev.y; w4.z = rx; w4.w = ry; }
                *(u32x4*)(op + db * 32 + 16 * gp + 8 * h) = w4;
            }
        if (h == 0) ((float*)(c.ws + WS_LD))[((size_t)br * NTOK + tok) * 4 + hh] = lt;
    }
}

__device__ __forceinline__ void phase_attn(const Ctx& c, int l) {
    for (int u = blockIdx.x; u < 1536; u += gridDim.x) {
        const int type = u >> 9;
        const int v = u & 511;
        const int k = v >> 8, i = v & 255, xcd = i & 7, slot = i >> 3;
        const int pair = k * 16 + xcd * 2 + (slot >> 4), b = pair >> 2, qb = slot & 15;
        int hh = pair & 3;
        if (type == 1 && k == 1) hh = 3 - hh;
        if (type == 0) attn_unit<0>(c, l, b, hh, qb, 0);
        else if (type == 1) attn_unit<1>(c, l, b, hh, qb, 0);
        else attn_unit<2>(c, l, b, hh, qb, 0);
    }
    unsigned* ticket = (unsigned*)(c.ws + WS_BAR) + TICKET_WORD0 + 64 * l;
    volatile LAS unsigned* tk = (volatile LAS unsigned*)(c.lds + 131072 + 16);
    for (;;) {
        __syncthreads();
        if (threadIdx.x == 0) tk[0] = __hip_atomic_fetch_add(ticket, 1u, __ATOMIC_RELAXED, __HIP_MEMORY_SCOPE_AGENT);
        __syncthreads();
        const int v = (int)tk[0];
        if (v >= 1536) break;
        const int br = v >> 9, w_ = v & 511;
        const int b = w_ >> 6, hh = (w_ >> 4) & 3, qb = w_ & 15;
        attn_unit<3>(c, l, b, hh, qb, br);
    }
}

__device__ __forceinline__ void phase_dmerge(const Ctx& c) {
    const float* ld = (const float*)(c.ws + WS_LD); u16* mix = (u16*)(c.ws + WS_MIX);
    for (int j = c.gtid; j < NTOK * 32; j += c.gthreads) {
        const int tok = j >> 5, ch = j & 31, hh = ch >> 3;
        float acc[8]; float lt = 0.f;
#pragma unroll
        for (int i = 0; i < 8; ++i) acc[i] = 0.f;
#pragma unroll
        for (int br = 0; br < 3; ++br) {
            const float lb = ld[((size_t)br * NTOK + tok) * 4 + hh]; lt += lb;
            float v[8]; load_bf16_vec<1>((const u16*)(c.ws + dpart_off(br)) + (size_t)tok * 256 + ch * 8, v);
#pragma unroll
            for (int i = 0; i < 8; ++i) acc[i] += lb * v[i];
        }
        const float inv = 1.f / lt;
#pragma unroll
        for (int i = 0; i < 8; ++i) acc[i] *= inv;
        store_bf16_vec<1>(mix + (size_t)tok * 1024 + 768 + ch * 8, acc);
    }
}

__device__ __forceinline__ void phase_ffn_fixup(const Ctx& c, int l) {
    const u16* hb = (const u16*)(c.ws + WS_HB); u16* act = (u16*)(c.ws + WS_ACT);
    const float* cw = c.p.in[I_CONVW] + (size_t)l * 3 * 5632; const float* cb = c.p.in[I_CONVB] + (size_t)l * 5632;
    for (int j = c.gtid; j < 512 * 2 * 352; j += c.gthreads) {
        const int ch = j % 352, e = (j / 352) & 1, blk = j / 704;
        const int row = blk * 64 + (e ? 63 : 0), s = row & 4095, c0 = ch * 8;
        const int hc = 256 * (c0 >> 7) + (c0 & 127);
        const u16* yu = e ? hb + ((size_t)blk * 4 + 2) * 5632 : hb + ((size_t)(blk - 1) * 4 + 3) * 5632;
        const u16* yc = hb + ((size_t)blk * 4 + (e ? 3 : 0)) * 5632;
        const u16* yd = e ? hb + ((size_t)(blk + 1) * 4 + 0) * 5632 : hb + ((size_t)blk * 4 + 1) * 5632;
        const bool hasu = e || s != 0, hasd = !e || s != 4095;
        float gu[8], gc[8], gd[8], vu[8], vc[8], vd[8];
        load_bf16_vec<1>(yc + hc, gc); load_bf16_vec<1>(yc + hc + 128, vc);
        if (hasu) { load_bf16_vec<1>(yu + hc, gu); load_bf16_vec<1>(yu + hc + 128, vu); }
        else {
#pragma unroll
            for (int i = 0; i < 8; ++i) { gu[i] = 0.f; vu[i] = 0.f; } }
        if (hasd) { load_bf16_vec<1>(yd + hc, gd); load_bf16_vec<1>(yd + hc + 128, vd); }
        else {
#pragma unroll
            for (int i = 0; i < 8; ++i) { gd[i] = 0.f; vd[i] = 0.f; } }
        float o[8];
#pragma unroll
        for (int i = 0; i < 8; ++i) {
            const float ug = gu[i] * cw[c0 + i] + gc[i] * cw[5632 + c0 + i] + gd[i] * cw[2 * 5632 + c0 + i] + cb[c0 + i];
            const float uv = vu[i] * cw[DFF + c0 + i] + vc[i] * cw[5632 + DFF + c0 + i] + vd[i] * cw[2 * 5632 + DFF + c0 + i] + cb[DFF + c0 + i];
            o[i] = ug / (1.f + __expf(-ug)) * uv;
        }
        store_bf16_vec<1>(act + (size_t)row * DFF + c0, o);
    }
}

#define XB_TMO      128
#define XB_XCNT(j)  (256  + 64 * (j))
#define XB_XSUB(j)  (1280 + 64 * (j))
#define XB_XGEN(j)  (2304 + 64 * (j))
#define XB_TOP      3328
#define XB_TOPGEN   3392
#define XCD_BAR_WORDS 3456
#define XB_SPIN_CAP (1u << 18)

__device__ __forceinline__ unsigned xb_ld(unsigned* p)              { return __hip_atomic_load(p, __ATOMIC_RELAXED, __HIP_MEMORY_SCOPE_AGENT); }
__device__ __forceinline__ unsigned xb_add(unsigned* p, unsigned v) { return __hip_atomic_fetch_add(p, v, __ATOMIC_RELAXED, __HIP_MEMORY_SCOPE_AGENT); }
__device__ __forceinline__ unsigned xb_xcc_id() { return (unsigned)__builtin_amdgcn_s_getreg((3 << 11) | 20) & 0xFu; }
#define XB_SPIN(cond, bar) do { unsigned _sp = 0; while (cond) { __builtin_amdgcn_s_sleep(1); \
    if ((++_sp & 255u) == 0u) { if (xb_ld(&(bar)[XB_TMO])) break; if (_sp > XB_SPIN_CAP) { atomicAdd(&(bar)[XB_TMO], 1u); break; } } } } while (0)

struct XcdBarrier {
    unsigned* bar; unsigned x;
    volatile LAS unsigned* st;
};

__device__ __forceinline__ XcdBarrier xcd_barrier_post(unsigned* bar, volatile LAS unsigned* st) {
    XcdBarrier b; b.bar = bar; b.x = xb_xcc_id(); b.st = st;
    if (threadIdx.x == 0) (void)xb_add(&bar[XB_XCNT(b.x)], 1u);
    return b;
}
__device__ __forceinline__ void xcd_barrier_complete(unsigned* bar, unsigned x, unsigned& nloc, unsigned& nx) {
    const unsigned G = gridDim.x * gridDim.y * gridDim.z;
    unsigned sum, cnt, mine, sp = 0u;
    for (;;) {
        sum = 0u; cnt = 0u; mine = 0u;
#pragma unroll
        for (unsigned j = 0; j < 16; ++j) { const unsigned c = xb_ld(&bar[XB_XCNT(j)]); sum += c; cnt += (c > 0u) ? 1u : 0u; mine = (j == x) ? c : mine; }
        if (sum == G) break;
        __builtin_amdgcn_s_sleep(1);
        if ((++sp & 255u) == 0u) { if (xb_ld(&bar[XB_TMO])) break; if (sp > XB_SPIN_CAP) { atomicAdd(&bar[XB_TMO], 1u); break; } }
    }
    nloc = mine > 0u ? mine : 1u; nx = cnt > 0u ? cnt : 1u;
}

__device__ __forceinline__ void xcd_barrier(const XcdBarrier& b) {
    asm volatile("s_waitcnt vmcnt(0)" ::: "memory");
    __syncthreads();
    if (threadIdx.x == 0) {
        unsigned* bar = b.bar;
        __builtin_amdgcn_s_waitcnt(0);
        unsigned nloc = b.st[0], nx = b.st[1];
        if (nloc == 0u) { xcd_barrier_complete(bar, b.x, nloc, nx); b.st[0] = nloc; b.st[1] = nx; }
        const unsigned old = xb_add(&bar[XB_XSUB(b.x)], 1u);
        const unsigned gen = old / nloc;
        if (old + 1u == (gen + 1u) * nloc) {
            __builtin_amdgcn_fence(__ATOMIC_RELEASE, "agent");
            asm volatile("s_waitcnt vmcnt(0)" ::: "memory");
            const unsigned og = xb_add(&bar[XB_TOP], 1u);
            const unsigned tg = og / nx;
            if (og + 1u == (tg + 1u) * nx) xb_add(&bar[XB_TOPGEN], 1u);
            else XB_SPIN(xb_ld(&bar[XB_TOPGEN]) == tg, bar);
            __builtin_amdgcn_fence(__ATOMIC_ACQUIRE, "agent");
            xb_add(&bar[XB_XGEN(b.x)], 1u);
            asm volatile("s_waitcnt vmcnt(0)" ::: "memory");
        } else {
            XB_SPIN(xb_ld(&bar[XB_XGEN(b.x)]) == gen, bar);
            __builtin_amdgcn_fence(__ATOMIC_ACQUIRE, "agent");
            asm volatile("s_waitcnt vmcnt(0)" ::: "memory");
        }
    }
    __syncthreads();
}


#define GSYNC() do { asm volatile("s_waitcnt vmcnt(0) lgkmcnt(0)" ::: "memory"); grid.sync(); asm volatile("" ::: "memory"); } while (0)
static_assert(TICKET_WORD0 == XCD_BAR_WORDS, "ticket words follow the barrier words");
#define XSYNC() do { asm volatile("s_waitcnt lgkmcnt(0)" ::: "memory"); xcd_barrier(xbar); asm volatile("" ::: "memory"); } while (0)
#define LAUNDER(c) do { int t_ = threadIdx.x; asm volatile("" : "+v"(t_)); (c).tid = t_; (c).lane = t_ & 63; (c).wave = __builtin_amdgcn_readfirstlane(t_ >> 6); \
        (c).gtid = blockIdx.x * NTHR + t_; (c).gwave = blockIdx.x * 8 + (c).wave; } while (0)
__global__ void __launch_bounds__(NTHR) fwd_kernel(Params p) {
    extern __shared__ __attribute__((aligned(16))) unsigned char lds_raw[];
    cg::grid_group grid = cg::this_grid();
    Ctx c;
    c.p = p; c.ws = p.ws; c.lds = (LAS unsigned char*)lds_raw;
    c.tid = threadIdx.x; c.lane = c.tid & 63; c.wave = __builtin_amdgcn_readfirstlane(c.tid >> 6);
    c.gtid = blockIdx.x * NTHR + c.tid; c.gthreads = gridDim.x * NTHR; c.gwave = blockIdx.x * 8 + c.wave; c.gwaves = gridDim.x * 8;
    u16* xn = (u16*)(p.ws + WS_XN);
    u16* proj = (u16*)(p.ws + WS_R1);
    volatile LAS unsigned* xst = (volatile LAS unsigned*)(c.lds + 131072);
    if (c.tid == 0) { xst[0] = 0u; xst[1] = 0u; }
    __syncthreads();
    const XcdBarrier xbar = xcd_barrier_post((unsigned*)(p.ws + WS_BAR), xst);
    GSYNC();
    for (int l = 0; l < DEPTH; ++l) {
        const float* xcur = l == 0 ? p.in[I_X] : p.out;
        LAUNDER(c);
        if (l == 0) phase_rope_table(c);
        LAUNDER(c);
        phase_wconv(c, l);
        LAUNDER(c);
        phase_rmsnorm(c, xcur, p.in[I_N1G] + l * 1024, xn);
        XSYNC();
        LAUNDER(c);
        g8::gemm_phase(c.lds, c.tid, xn, 1024, (const u16*)(p.ws + WS_BT_IN), 1024, NTOK / 256, INWP / 256, g8::EpiBf16{proj, INWP});
        XSYNC();
        LAUNDER(c);
        g8::gemm_phase(c.lds, c.tid, proj + 1280, INWP, (const u16*)(p.ws + WS_BT_MLA), 512, NTOK / 256, 4, g8::EpiBf16{xn, 1024});
        XSYNC();
        LAUNDER(c);
        phase_pp(c, l);
        XSYNC();
        LAUNDER(c);
        phase_attn(c, l);
        XSYNC();
        LAUNDER(c);
        phase_dmerge(c);
        XSYNC();
        LAUNDER(c);
        g8::gemm_phase(c.lds, c.tid, (const u16*)(p.ws + WS_MIX), 1024, (const u16*)(p.ws + WS_BT_OUT), 1024, NTOK / 256, 4, g8::EpiRes{xcur, p.out});
        XSYNC();
        LAUNDER(c);
        phase_rmsnorm(c, p.out, p.in[I_N2G] + l * 1024, xn);
        XSYNC();
        LAUNDER(c);
        g8::gemm_phase(c.lds, c.tid, xn, 1024, (const u16*)(p.ws + WS_BT_UP), 1024, NTOK / 256, 22,
                       g8::EpiConv{(u16*)(p.ws + WS_ACT), (u16*)(p.ws + WS_HB), p.in[I_CONVW] + (size_t)l * 3 * 5632, p.in[I_CONVB] + (size_t)l * 5632});
        XSYNC();
        LAUNDER(c);
        phase_ffn_fixup(c, l);
        XSYNC();
        LAUNDER(c);
        g8::gemm_phase(c.lds, c.tid, (const u16*)(p.ws + WS_ACT), DFF, (const u16*)(p.ws + WS_BT_DN), DFF, NTOK / 256, 4, g8::EpiRes{p.out, p.out});
        XSYNC();
    }
}

extern "C" void kernel_launch(void* const* d_in, const int* in_sizes, int n_in, void* d_out, int out_size, void* d_ws, size_t ws_size,
                              hipStream_t stream) {
    static int grid_blocks = 0;
    if (!grid_blocks) {
        int dev = 0, cus = 0, per_cu = 0;
        (void)hipGetDevice(&dev);
        (void)hipDeviceGetAttribute(&cus, hipDeviceAttributeMultiprocessorCount, dev);
        (void)hipFuncSetAttribute((const void*)fwd_kernel, hipFuncAttributeMaxDynamicSharedMemorySize, LDS_BYTES);
        (void)hipOccupancyMaxActiveBlocksPerMultiprocessor(&per_cu, (const void*)fwd_kernel, NTHR, LDS_BYTES);
        if (per_cu < 1) per_cu = 1;
        grid_blocks = cus * per_cu;
        if (ws_size < WS_END || n_in != 26) fprintf(stderr, "kernel_launch: unexpected ws_size %zu (need %zu) or n_in %d\n", ws_size, (size_t)WS_END, n_in);
    }
    (void)hipMemsetAsync((unsigned char*)d_ws + WS_BAR, 0, (XCD_BAR_WORDS + 64 * DEPTH) * sizeof(unsigned), stream);
    Params p{};
    for (int i = 0; i < 26 && i < n_in; ++i) p.in[i] = (const float*)d_in[i];
    p.out = (float*)d_out;
    p.ws = (unsigned char*)d_ws;
    void* args[] = {&p};
    hipError_t e = hipLaunchCooperativeKernel((const void*)fwd_kernel, dim3(grid_blocks), dim3(NTHR), args, LDS_BYTES, stream);
    if (e != hipSuccess) fprintf(stderr, "cooperative launch failed: %s (grid %d)\n", hipGetErrorString(e), grid_blocks);
}
```

```cpp
#include <hip/hip_runtime.h>
#include <hip/hip_cooperative_groups.h>
#include <cstdio>
#include <cstdint>
namespace cg = cooperative_groups;

#define LAS __attribute__((address_space(3)))
typedef unsigned short u16;
typedef short bf16x8 __attribute__((ext_vector_type(8)));
typedef float f32x4 __attribute__((ext_vector_type(4)));
typedef float f32x16 __attribute__((ext_vector_type(16)));
typedef unsigned u32x4 __attribute__((ext_vector_type(4)));
typedef unsigned u32x2 __attribute__((ext_vector_type(2)));

constexpr int NTOK = 32768, SEQ = 4096, NB = 8, DM = 1024, DEPTH = 4;
constexpr int INW = 2464, INWP = 2560, DFF = 2816;
constexpr float EPS = 1e-6f;
constexpr float LOG2E = 1.4426950408889634f;
constexpr int LDS_BYTES = 131072 + 64;
constexpr int NTHR = 512;

enum { I_X = 0, I_N1G, I_WIN, I_AQN, I_AKN, I_BQN, I_BKN, I_LQ1, I_LK1, I_LQ2, I_LK2, I_BSUB, I_CQAG, I_CKVAG, I_WQB, I_WKVB, I_CQN, I_CKN,
       I_DQN, I_DKN, I_WOUT, I_N2G, I_WUP, I_CONVW, I_CONVB, I_WDOWN };

constexpr size_t WS_BT_IN = 0;
constexpr size_t WS_BT_MLA = WS_BT_IN + (size_t)INWP * 1024 * 2;
constexpr size_t WS_BT_OUT = WS_BT_MLA + (size_t)1024 * 512 * 2;
constexpr size_t WS_BT_UP = WS_BT_OUT + (size_t)1024 * 1024 * 2;
constexpr size_t WS_BT_DN = WS_BT_UP + (size_t)5632 * 1024 * 2;
constexpr size_t WS_ROPE = WS_BT_DN + (size_t)1024 * 2816 * 2;
constexpr size_t WS_LD = WS_ROPE + (size_t)4096 * 16 * 8;
constexpr size_t WS_XN = WS_LD + (size_t)3 * NTOK * 4 * 4;
constexpr size_t WS_R1 = WS_XN + (size_t)NTOK * 1024 * 2;
constexpr size_t WS_MIX = WS_XN;
constexpr size_t WS_QKV = WS_R1 + (size_t)NTOK * INWP * 2;
constexpr size_t QKV_TOK = (size_t)NTOK * 2;
constexpr size_t WS_QA = WS_QKV;
constexpr size_t WS_KA = WS_QA + 256 * QKV_TOK;
constexpr size_t WS_VTA = WS_KA + 128 * QKV_TOK;
constexpr size_t WS_QB = WS_VTA + 128 * QKV_TOK;
constexpr size_t WS_KB = WS_QB + 256 * QKV_TOK;
constexpr size_t WS_VTB = WS_KB + 256 * QKV_TOK;
constexpr size_t WS_QC = WS_VTB + 256 * QKV_TOK;
constexpr size_t WS_KC = WS_QC + 384 * QKV_TOK;
constexpr size_t WS_VTC = WS_KC + 384 * QKV_TOK;
constexpr size_t WS_QD = WS_VTC + 256 * QKV_TOK;
constexpr size_t WS_KD = WS_QD + 256 * QKV_TOK;
constexpr size_t WS_VTD = WS_KD + 256 * QKV_TOK;
constexpr size_t WS_END = WS_VTD + 768 * QKV_TOK;
constexpr size_t WS_ACT = WS_R1;
constexpr size_t WS_HB = WS_ACT + (size_t)NTOK * 2816 * 2;
static_assert(WS_HB + (size_t)512 * 4 * 5632 * 2 <= WS_END, "ffn overlay");
static_assert(WS_END <= (size_t)536870912, "workspace");

constexpr int TICKET_WORD0 = 3456;
constexpr size_t WS_BAR = WS_END;
__host__ __device__ constexpr size_t dpart_off(int br) { return br == 0 ? WS_QA : (br == 1 ? WS_QB : WS_QD); }
struct Params {
    const float* in[26];
    float* out;
    unsigned char* ws;
};

typedef __bf16 bf16x2_t __attribute__((ext_vector_type(2)));
typedef float f32x2_t __attribute__((ext_vector_type(2)));
__device__ __forceinline__ unsigned cvt_pk_bf16(float lo, float hi) { f32x2_t v = {lo, hi}; bf16x2_t b = __builtin_convertvector(v, bf16x2_t); return __builtin_bit_cast(unsigned, b); }
__device__ __forceinline__ float bf_lo(unsigned w) { return __uint_as_float(w << 16); }
__device__ __forceinline__ float bf_hi(unsigned w) { return __uint_as_float(w & 0xffff0000u); }
__device__ __forceinline__ float wave_sum(float v) {
#pragma unroll
    for (int o = 1; o < 64; o <<= 1) v += __shfl_xor(v, o);
    return v;
}
__device__ __forceinline__ float wave_max(float v) {
#pragma unroll
    for (int o = 1; o < 64; o <<= 1) v = fmaxf(v, __shfl_xor(v, o));
    return v;
}
__device__ __forceinline__ float wave_absmax(const float* g, int n, int lane) {
    float v = lane < n ? fabsf(g[lane]) : 0.f;
    if (lane + 64 < n) v = fmaxf(v, fabsf(g[lane + 64]));
    return wave_max(v);
}
template <int N8> __device__ __forceinline__ void load_bf16_vec(const u16* src, float* v) {
#pragma unroll
    for (int c = 0; c < N8; ++c) {
        const u32x4 w = *(const u32x4*)(src + 8 * c);
        v[8 * c + 0] = bf_lo(w.x); v[8 * c + 1] = bf_hi(w.x); v[8 * c + 2] = bf_lo(w.y); v[8 * c + 3] = bf_hi(w.y);
        v[8 * c + 4] = bf_lo(w.z); v[8 * c + 5] = bf_hi(w.z); v[8 * c + 6] = bf_lo(w.w); v[8 * c + 7] = bf_hi(w.w);
    }
}
template <int N8> __device__ __forceinline__ void store_bf16_vec(u16* dst, const float* v) {
#pragma unroll
    for (int c = 0; c < N8; ++c) {
        u32x4 w;
        w.x = cvt_pk_bf16(v[8 * c + 0], v[8 * c + 1]); w.y = cvt_pk_bf16(v[8 * c + 2], v[8 * c + 3]);
        w.z = cvt_pk_bf16(v[8 * c + 4], v[8 * c + 5]); w.w = cvt_pk_bf16(v[8 * c + 6], v[8 * c + 7]);
        *(u32x4*)(dst + 8 * c) = w;
    }
}
template <int N8> __device__ __forceinline__ float sumsq_bf16(const u16* src) {
    float s = 0.f;
#pragma unroll
    for (int c = 0; c < N8; ++c) {
        const u32x4 w = *(const u32x4*)(src + 8 * c);
        float a;
        a = bf_lo(w.x); s += a * a; a = bf_hi(w.x); s += a * a; a = bf_lo(w.y); s += a * a; a = bf_hi(w.y); s += a * a;
        a = bf_lo(w.z); s += a * a; a = bf_hi(w.z); s += a * a; a = bf_lo(w.w); s += a * a; a = bf_hi(w.w); s += a * a;
    }
    return s;
}

namespace g8 {
constexpr int BM = 256, BK = 64, HALF = 128, HTB = HALF * BK * 2, NXCD = 8, WGM = 8;
__device__ __forceinline__ int lds_byte(int r, int c) { const int st = (r >> 4) * 2 + (c >> 5), rr = r & 15, cc = c & 31, ob = rr * 64 + cc * 2; return st * 1024 + (ob ^ (((ob >> 9) & 1) << 5)); }
__device__ __forceinline__ void stage_rc(int b, int& R, int& C) { const int st = b / 1024, sb = b % 1024, swz = sb ^ (((sb >> 9) & 1) << 5); R = (st >> 1) * 16 + swz / 64; C = (st & 1) * 32 + (swz % 64) / 2; }

__device__ __forceinline__ int perm32(int rho) { const int n = rho >> 4, i = rho & 15; return 8 * (i >> 2) + 4 * n + (i & 3); }
__device__ __forceinline__ bool unit_at(int i, int G, int c, int nM, int nN, int& pm, int& pn) {
    const int nwg = nM * nN; const long Lx = (long)i * G + c; if (Lx >= nwg) return false;
    int wgid = (int)Lx; { const int q = nwg / NXCD, r = nwg % NXCD, xcd = wgid % NXCD, off = wgid / NXCD; wgid = (xcd < r ? xcd * (q + 1) : r * (q + 1) + (xcd - r) * q) + off; }
    const int nig = WGM * nN, gid = wgid / nig, fm = gid * WGM, gsz = (nM - fm) < WGM ? (nM - fm) : WGM;
    pm = fm + ((wgid % nig) % gsz); pn = (wgid % nig) / gsz; return true;
}

struct EpiBf16 {
    static constexpr bool PERM = true;
    u16* O; int ldc;
    __device__ __forceinline__ void operator()(const f32x4 (&acc)[2][2][4][2], int brow, int bcol, int wr, int wc, int fr, int fq) const {
#pragma unroll
        for (int ai = 0; ai < 2; ++ai)
#pragma unroll
            for (int m = 0; m < 4; ++m) {
                u16* rowp = O + (size_t)(brow + ai * HALF + wr * 64 + m * 16 + fr) * ldc + bcol + wc * 32 + 8 * fq;
#pragma unroll
                for (int bj = 0; bj < 2; ++bj) {
                    const f32x4 v0 = acc[ai][bj][m][0], v1 = acc[ai][bj][m][1];
                    u32x4 w; w.x = cvt_pk_bf16(v0[0], v0[1]); w.y = cvt_pk_bf16(v0[2], v0[3]); w.z = cvt_pk_bf16(v1[0], v1[1]); w.w = cvt_pk_bf16(v1[2], v1[3]);
                    *(u32x4*)(rowp + bj * HALF) = w;
                }
            }
    }
};
struct EpiRes {
    static constexpr bool PERM = false;
    const float* xin; float* xout;
    __device__ __forceinline__ void operator()(const f32x4 (&acc)[2][2][4][2], int brow, int bcol, int wr, int wc, int fr, int fq) const {
#pragma unroll
        for (int ai = 0; ai < 2; ++ai)
#pragma unroll
            for (int m = 0; m < 4; ++m) {
                const size_t off = (size_t)(brow + ai * HALF + wr * 64 + m * 16 + fr) * 1024 + bcol + wc * 32 + 4 * fq;
#pragma unroll
                for (int bj = 0; bj < 2; ++bj)
#pragma unroll
                    for (int n = 0; n < 2; ++n) {
                        const f32x4 b = *(const f32x4*)(xin + off + bj * HALF + n * 16);
                        *(f32x4*)(xout + off + bj * HALF + n * 16) = b + acc[ai][bj][m][n];
                    }
            }
    }
};

__device__ __forceinline__ float dpp_from_prev(float v) { return __int_as_float(__builtin_amdgcn_update_dpp(0, __float_as_int(v), 0x121  , 0xf, 0xf, false)); }
__device__ __forceinline__ float dpp_from_next(float v) { return __int_as_float(__builtin_amdgcn_update_dpp(0, __float_as_int(v), 0x12F  , 0xf, 0xf, false)); }
struct EpiConv {
    static constexpr bool PERM = false;
    u16* act; u16* hb; const float* cw; const float* cb;
    __device__ __forceinline__ void operator()(const f32x4 (&acc)[2][2][4][2], int brow, int bcol, int wr, int wc, int fr, int fq) const {
        const int lane = fq * 16 + fr, lup = fq * 16 + ((fr + 15) & 15), ldn = fq * 16 + ((fr + 1) & 15);
        const int pn = bcol >> 8;
#pragma unroll
        for (int n = 0; n < 2; ++n) {
            const int cg = 128 * pn + wc * 32 + n * 16 + 4 * fq;
            const f32x4 w0g = *(const f32x4*)(cw + cg), w1g = *(const f32x4*)(cw + 5632 + cg), w2g = *(const f32x4*)(cw + 2 * 5632 + cg), bg = *(const f32x4*)(cb + cg);
            const f32x4 w0v = *(const f32x4*)(cw + DFF + cg), w1v = *(const f32x4*)(cw + 5632 + DFF + cg), w2v = *(const f32x4*)(cw + 2 * 5632 + DFF + cg), bv = *(const f32x4*)(cb + DFF + cg);
#pragma unroll
            for (int ai = 0; ai < 2; ++ai) {
                const int rblk = brow + ai * HALF + wr * 64;
                f32x4 Rgp, Rvp, Lgc, Lvc;
#pragma unroll
                for (int j = 0; j < 4; ++j) { Lgc[j] = dpp_from_next(acc[ai][0][0][n][j]); Lvc[j] = dpp_from_next(acc[ai][1][0][n][j]); Rgp[j] = 0.f; Rvp[j] = 0.f; }
#pragma unroll
                for (int m = 0; m < 4; ++m) {
                    const f32x4 G = acc[ai][0][m][n], V = acc[ai][1][m][n];
                    f32x4 Rgc, Rvc, Lgn = Lgc, Lvn = Lvc;
#pragma unroll
                    for (int j = 0; j < 4; ++j) { Rgc[j] = dpp_from_prev(G[j]); Rvc[j] = dpp_from_prev(V[j]); }
                    if (m < 3) {
#pragma unroll
                        for (int j = 0; j < 4; ++j) { Lgn[j] = dpp_from_next(acc[ai][0][m < 3 ? m + 1 : 3][n][j]); Lvn[j] = dpp_from_next(acc[ai][1][m < 3 ? m + 1 : 3][n][j]); }
                    }
                    const f32x4 upg = fr > 0 ? Rgc : Rgp, upv = fr > 0 ? Rvc : Rvp;
                    const f32x4 dng = fr < 15 ? Lgc : Lgn, dnv = fr < 15 ? Lvc : Lvn;
                    const f32x4 ug = upg * w0g + G * w1g + dng * w2g + bg;
                    const f32x4 uv = upv * w0v + V * w1v + dnv * w2v + bv;
                    f32x4 o;
#pragma unroll
                    for (int j = 0; j < 4; ++j) o[j] = ug[j] * __builtin_amdgcn_rcpf(1.f + __expf(-ug[j])) * uv[j];
                    const int row = rblk + m * 16 + fr;
                    const bool seam = (m == 0 && fr == 0) || (m == 3 && fr == 15);
                    if (!seam) { u32x2 w; w.x = cvt_pk_bf16(o[0], o[1]); w.y = cvt_pk_bf16(o[2], o[3]); *(u32x2*)(act + (size_t)row * DFF + cg) = w; }
                    if ((m == 0 && fr < 2) || (m == 3 && fr > 13)) {
                        const int which = m == 0 ? fr : fr - 12;
                        u16* hp = hb + ((size_t)(row >> 6) * 4 + which) * 5632 + bcol + wc * 32 + n * 16 + 4 * fq;
                        u32x2 wg, wv; wg.x = cvt_pk_bf16(G[0], G[1]); wg.y = cvt_pk_bf16(G[2], G[3]); wv.x = cvt_pk_bf16(V[0], V[1]); wv.y = cvt_pk_bf16(V[2], V[3]);
                        *(u32x2*)hp = wg; *(u32x2*)(hp + HALF) = wv;
                    }
                    Rgp = Rgc; Rvp = Rvc; Lgc = Lgn; Lvc = Lvn;
                }
                asm volatile("" ::: "memory");
            }
        }
        (void)lane;
    }
};

template <class Epi>
__device__ __forceinline__ void gemm_phase(LAS unsigned char* lds, int tid_in, const u16* A, int lda, const u16* Bt, int K, int nM, int nN, const Epi& E) {
    const int tid = tid_in, wid = __builtin_amdgcn_readfirstlane(tid >> 6), lane = tid & 63, wr = wid >> 2, wc = wid & 3, fr = lane & 15, fq = lane >> 4;
    const int nt = K / BK;
    unsigned offA[2], offB[2];
#pragma unroll
    for (int i = 0; i < 2; ++i) { int R, C; stage_rc(tid * 16 + i * 8192, R, C); const int Rb = Epi::PERM ? ((R & ~31) + perm32(R & 31)) : R; offA[i] = (unsigned)(R * lda + C); offB[i] = (unsigned)(Rb * K + C); }
    const unsigned ldsw = (unsigned)wid * 1024u;
    const int aoff = lds_byte(wr * 64 + fr, fq * 8), boff = lds_byte(wc * 32 + fr, fq * 8);
#define G8_SA(b, h) (((b) * 2 + (h)) * HTB)
#define G8_SB(b, h) ((4 + (b) * 2 + (h)) * HTB)
#define G8_STAGE(bufoff, gptr, voff) do { _Pragma("unroll") for (int _i = 0; _i < 2; ++_i) \
        __builtin_amdgcn_global_load_lds((const unsigned*)((gptr) + (voff)[_i]), (LAS unsigned*)(lds + (bufoff) + ldsw + _i * 8192), 16, 0, 0); } while (0)
#define G8_LDA(dst, b, h) do { _Pragma("unroll") for (int m = 0; m < 4; ++m) _Pragma("unroll") for (int k = 0; k < 2; ++k) dst[m][k] = *(const LAS bf16x8*)(lds + G8_SA(b, h) + aoff + m * 2048 + k * 1024); } while (0)
#define G8_LDB(dst, b, h) do { _Pragma("unroll") for (int n = 0; n < 2; ++n) _Pragma("unroll") for (int k = 0; k < 2; ++k) dst[n][k] = *(const LAS bf16x8*)(lds + G8_SB(b, h) + boff + n * 2048 + k * 1024); } while (0)
#define G8_MMA(ai, bj, At, Bq) do { __builtin_amdgcn_s_setprio(1); _Pragma("unroll") for (int m = 0; m < 4; ++m) _Pragma("unroll") for (int n = 0; n < 2; ++n) _Pragma("unroll") for (int k = 0; k < 2; ++k) \
        acc[ai][bj][m][n] = __builtin_amdgcn_mfma_f32_16x16x32_bf16(Bq[n][k], At[m][k], acc[ai][bj][m][n], 0, 0, 0); __builtin_amdgcn_s_setprio(0); } while (0)
#define G8_WAIT_V(n) asm volatile("s_waitcnt vmcnt(" #n ")" ::: "memory")
#define G8_WAIT_L(n) asm volatile("s_waitcnt lgkmcnt(" #n ")" ::: "memory")
#define G8_BAR __builtin_amdgcn_s_barrier()
#define G8_SCHED __builtin_amdgcn_sched_barrier(0)
    int pm, pn, npm = 0, npn = 0, ui = 0;
    if (!unit_at(0, gridDim.x, blockIdx.x, nM, nN, pm, pn)) return;
    f32x4 acc[2][2][4][2];
#pragma unroll
    for (int a = 0; a < 2; ++a)
#pragma unroll
        for (int b = 0; b < 2; ++b)
#pragma unroll
            for (int m = 0; m < 4; ++m)
#pragma unroll
                for (int n = 0; n < 2; ++n) acc[a][b][m][n] = (f32x4){0.f, 0.f, 0.f, 0.f};
    bf16x8 At[4][2], B0[2][2], B1[2][2];
    const size_t hA = (size_t)HALF * lda, hB = (size_t)HALF * K;
    const u16* cA = A + (size_t)pm * BM * lda;
    const u16* cB = Bt + (size_t)pn * BM * K;
    G8_STAGE(G8_SB(0, 0), cB, offB); G8_STAGE(G8_SB(0, 1), cB + hB, offB); G8_STAGE(G8_SA(0, 0), cA, offA); G8_STAGE(G8_SA(0, 1), cA + hA, offA);
    if (wr == 1) G8_BAR;
    G8_WAIT_V(2); G8_BAR;
    G8_STAGE(G8_SB(1, 0), cB + BK, offB); G8_STAGE(G8_SA(1, 0), cA + BK, offA); G8_STAGE(G8_SB(1, 1), cB + hB + BK, offB);
    G8_WAIT_V(6); G8_BAR;
    for (;;) {
        const bool has_next = unit_at(ui + 1, gridDim.x, blockIdx.x, nM, nN, npm, npn);
        const u16* nA = has_next ? A + (size_t)npm * BM * lda : cA;
        const u16* nB = has_next ? Bt + (size_t)npn * BM * K : cB;
        for (int t = 0; t < nt; t += 2) {
            const bool last = (t == nt - 2);
            const u16* a1 = cA + (size_t)(t + 1) * BK;
            const u16* a2 = last ? nA : cA + (size_t)(t + 2) * BK;
            const u16* b2 = last ? nB : cB + (size_t)(t + 2) * BK;
            const u16* a3 = a2 + BK; const u16* b3 = b2 + BK;
            G8_LDB(B0, 0, 0); G8_LDB(B1, 0, 1); G8_SCHED; G8_LDA(At, 0, 0); G8_STAGE(G8_SA(1, 1), a1 + hA, offA);
            G8_WAIT_V(8); G8_WAIT_L(0); G8_BAR; G8_MMA(0, 0, At, B0); G8_MMA(0, 1, At, B1); G8_BAR; G8_SCHED;
            G8_LDA(At, 0, 1); G8_STAGE(G8_SB(0, 0), b2, offB); G8_STAGE(G8_SB(0, 1), b2 + hB, offB); G8_STAGE(G8_SA(0, 0), a2, offA);
            G8_WAIT_V(8); G8_WAIT_L(0); G8_BAR; G8_MMA(1, 0, At, B0); G8_MMA(1, 1, At, B1); G8_BAR; G8_SCHED;
            G8_LDB(B0, 1, 0); G8_LDB(B1, 1, 1); G8_SCHED; G8_LDA(At, 1, 0); G8_STAGE(G8_SA(0, 1), a2 + hA, offA);
            G8_WAIT_V(8); G8_WAIT_L(0); G8_BAR; G8_MMA(0, 0, At, B0); G8_MMA(0, 1, At, B1); G8_BAR; G8_SCHED;
            G8_LDA(At, 1, 1); G8_STAGE(G8_SB(1, 0), b3, offB); G8_STAGE(G8_SB(1, 1), b3 + hB, offB); G8_STAGE(G8_SA(1, 0), a3, offA);
            G8_WAIT_V(8); G8_WAIT_L(0); G8_BAR; G8_MMA(1, 0, At, B0); G8_MMA(1, 1, At, B1); G8_BAR; G8_SCHED;
        }
        if (wr == 0) G8_BAR;
        E(acc, pm * BM, pn * BM, wr, wc, fr, fq);
        if (!has_next) break;
#pragma unroll
        for (int a = 0; a < 2; ++a)
#pragma unroll
            for (int b = 0; b < 2; ++b)
#pragma unroll
                for (int m = 0; m < 4; ++m)
#pragma unroll
                    for (int n = 0; n < 2; ++n) acc[a][b][m][n] = (f32x4){0.f, 0.f, 0.f, 0.f};
        pm = npm; pn = npn; cA = nA; cB = nB; ++ui;
        if (wr == 1) G8_BAR;
    }
    G8_WAIT_V(0);
    G8_BAR;
}
}

struct Ctx {
    Params p; unsigned char* ws; LAS unsigned char* lds; int tid, lane, wave, gtid, gthreads, gwave, gwaves;
};

__device__ __forceinline__ void wconv_tile(const Ctx& c, const float* src, int ldsrc, int Nsrc, int k0s, int n0s, const float* kgain, u16* dst, int lddst, int n0d, int k0d) {
    LAS float* T = (LAS float*)c.lds;
    const int tid = c.tid;
    {
        const int k = tid >> 3, n8 = (tid & 7) * 8;
        f32x4 a = {0.f, 0.f, 0.f, 0.f}, b = {0.f, 0.f, 0.f, 0.f};
        if (src != nullptr && n0s + n8 < Nsrc) {
            const float* sp = src + (size_t)(k0s + k) * ldsrc + n0s + n8;
            a = *(const f32x4*)sp; b = *(const f32x4*)(sp + 4);
            if (kgain) { const float g = kgain[k0s + k]; a = a * g; b = b * g; }
        }
        LAS float* tp = T + k * 65 + n8;
        tp[0] = a[0]; tp[1] = a[1]; tp[2] = a[2]; tp[3] = a[3]; tp[4] = b[0]; tp[5] = b[1]; tp[6] = b[2]; tp[7] = b[3];
    }
    __syncthreads();
    {
        const int n = tid >> 3, k8 = (tid & 7) * 8;
        const LAS float* tp = T + k8 * 65 + n;
        u32x4 w;
        w.x = cvt_pk_bf16(tp[0], tp[65]); w.y = cvt_pk_bf16(tp[130], tp[195]); w.z = cvt_pk_bf16(tp[260], tp[325]); w.w = cvt_pk_bf16(tp[390], tp[455]);
        *(u32x4*)(dst + (size_t)(n0d + n) * lddst + k0d + k8) = w;
    }
    __syncthreads();
}

__device__ __forceinline__ void phase_wconv(const Ctx& c, int l) {
    u16* bt_in = (u16*)(c.ws + WS_BT_IN); u16* bt_mla = (u16*)(c.ws + WS_BT_MLA); u16* bt_out = (u16*)(c.ws + WS_BT_OUT);
    u16* bt_up = (u16*)(c.ws + WS_BT_UP); u16* bt_dn = (u16*)(c.ws + WS_BT_DN);
    const float* w_in = c.p.in[I_WIN] + (size_t)l * 1024 * INW;
    const float* wqb = c.p.in[I_WQB] + (size_t)l * 256 * 384;
    const float* wkvb = c.p.in[I_WKVB] + (size_t)l * 128 * 512;
    const float* w_out = c.p.in[I_WOUT] + (size_t)l * 1024 * 1024;
    const float* w_up = c.p.in[I_WUP] + (size_t)l * 1024 * 5632;
    const float* w_dn = c.p.in[I_WDOWN] + (size_t)l * DFF * 1024;
    constexpr int T_IN = 40 * 16, T_MLA = 16 * 8, T_OUT = 16 * 16, T_UP = 88 * 16, T_DN = 16 * 44;
    constexpr int T_ALL = T_IN + T_MLA + T_OUT + T_UP + T_DN;
    for (int it = blockIdx.x; it < T_ALL; it += gridDim.x) {
        int r = it;
        if (r < T_IN) { const int nt = r / 16, kt = r % 16; wconv_tile(c, w_in, INW, INW, kt * 64, nt * 64, nullptr, bt_in, 1024, nt * 64, kt * 64); continue; }
        r -= T_IN;
        if (r < T_MLA) {
            const int nt = r / 8, kt = r % 8;
            if (nt < 6 && kt < 4) wconv_tile(c, wqb, 384, 384, kt * 64, nt * 64, c.p.in[I_CQAG] + l * 256, bt_mla, 512, nt * 64, kt * 64);
            else if (nt >= 6 && nt < 14 && kt >= 4 && kt < 6) wconv_tile(c, wkvb, 512, 512, (kt - 4) * 64, (nt - 6) * 64, c.p.in[I_CKVAG] + l * 128, bt_mla, 512, nt * 64, kt * 64);
            else wconv_tile(c, nullptr, 0, 0, 0, 0, nullptr, bt_mla, 512, nt * 64, kt * 64);
            continue;
        }
        r -= T_MLA;
        if (r < T_OUT) { const int nt = r / 16, kt = r % 16; wconv_tile(c, w_out, 1024, 1024, kt * 64, nt * 64, nullptr, bt_out, 1024, nt * 64, kt * 64); continue; }
        r -= T_OUT;
        if (r < T_UP) { const int nt = r / 16, kt = r % 16, pn = nt >> 2, q = nt & 3;
            const int n0s = q < 2 ? 128 * pn + 64 * q : DFF + 128 * pn + 64 * (q - 2);
            wconv_tile(c, w_up, 5632, 5632, kt * 64, n0s, nullptr, bt_up, 1024, nt * 64, kt * 64); continue; }
        r -= T_UP;
        { const int nt = r / 44, kt = r % 44; wconv_tile(c, w_dn, 1024, 1024, kt * 64, nt * 64, nullptr, bt_dn, DFF, nt * 64, kt * 64); }
    }
}

__device__ __forceinline__ void phase_rope_table(const Ctx& c) {
    float2* tab = (float2*)(c.ws + WS_ROPE);
    for (int i = c.gtid; i < 4096 * 16; i += c.gthreads) {
        const int pos = i >> 4, fi = i & 15;
        const int f4 = fi & 3, f10 = fi >> 2;
        const float fb = f4 == 0 ? 1.0f : (f4 == 1 ? 0.5623413251903491f : (f4 == 2 ? 0.31622776601683794f : 0.1778279410038923f));
        const float fm = f10 == 0 ? 1.0f : (f10 == 1 ? 0.1f : (f10 == 2 ? 0.01f : 0.001f));
        const float f = fb * fm;
        const float ang = (float)pos * f;
        const double rev = (double)ang * 0.15915494309189535;
        const float fr = (float)(rev - rint(rev));
        tab[i] = make_float2(__builtin_amdgcn_cosf(fr), __builtin_amdgcn_sinf(fr));
    }
}

__device__ __forceinline__ void phase_rmsnorm(const Ctx& c, const float* x, const float* g, u16* xn) {
    f32x4 gv[4];
#pragma unroll
    for (int j = 0; j < 4; ++j) gv[j] = *(const f32x4*)(g + (j * 64 + c.lane) * 4);
    for (int row = c.gwave; row < NTOK; row += 2 * c.gwaves) {
        const int row2 = row + c.gwaves; const bool has2 = row2 < NTOK;
        const f32x4* xr = (const f32x4*)(x + (size_t)row * 1024) + c.lane;
        const f32x4* xr2 = (const f32x4*)(x + (size_t)(has2 ? row2 : row) * 1024) + c.lane;
        f32x4 v[4], v2[4]; float s = 0.f, s2 = 0.f;
#pragma unroll
        for (int j = 0; j < 4; ++j) { v[j] = xr[64 * j]; v2[j] = xr2[64 * j]; }
#pragma unroll
        for (int j = 0; j < 4; ++j) { s += (v[j][0] * v[j][0] + v[j][1] * v[j][1]) + (v[j][2] * v[j][2] + v[j][3] * v[j][3]); s2 += (v2[j][0] * v2[j][0] + v2[j][1] * v2[j][1]) + (v2[j][2] * v2[j][2] + v2[j][3] * v2[j][3]); }
        const float rs = rsqrtf(wave_sum(s) * (1.f / 1024.f) + EPS), rs2 = rsqrtf(wave_sum(s2) * (1.f / 1024.f) + EPS);
        u32x2* o = (u32x2*)(xn + (size_t)row * 1024) + c.lane;
#pragma unroll
        for (int j = 0; j < 4; ++j) { u32x2 w; w.x = cvt_pk_bf16(v[j][0] * rs * gv[j][0], v[j][1] * rs * gv[j][1]); w.y = cvt_pk_bf16(v[j][2] * rs * gv[j][2], v[j][3] * rs * gv[j][3]); o[64 * j] = w; }
        if (has2) { u32x2* o2 = (u32x2*)(xn + (size_t)row2 * 1024) + c.lane;
#pragma unroll
            for (int j = 0; j < 4; ++j) { u32x2 w; w.x = cvt_pk_bf16(v2[j][0] * rs2 * gv[j][0], v2[j][1] * rs2 * gv[j][1]); w.y = cvt_pk_bf16(v2[j][2] * rs2 * gv[j][2], v2[j][3] * rs2 * gv[j][3]); o2[64 * j] = w; } }
    }
}

template <int MODE, bool ROPE>
__device__ __forceinline__ void pp_vec64(const u16* src, u16* dst, const float* gain, int s, float prescale, const float2* tab) {
    float r1, r2;
    if (MODE == 0) { r1 = rsqrtf(sumsq_bf16<8>(src) * (1.f / 64.f) + EPS) * prescale; r2 = r1; }
    else { r1 = rsqrtf(sumsq_bf16<4>(src) * (1.f / 32.f) + EPS) * prescale; r2 = rsqrtf(sumsq_bf16<4>(src + 32) * (1.f / 32.f) + EPS) * prescale; }
#pragma unroll
    for (int hf = 0; hf < 2; ++hf) {
        float v[32]; load_bf16_vec<4>(src + 32 * hf, v);
        const float rr = hf == 0 ? r1 : r2;
        const float* gp = gain + (MODE == 0 ? 32 * hf : 0);
#pragma unroll
        for (int i = 0; i < 32; ++i) v[i] = v[i] * rr * gp[i];
        if (ROPE) {
            const float2* t = tab + (hf == 0 ? (s >> 6) : (s & 63)) * 16;
#pragma unroll
            for (int i = 0; i < 16; ++i) { const float2 a = t[i]; const float x1 = v[i], x2 = v[16 + i]; v[i] = x1 * a.x - x2 * a.y; v[16 + i] = x1 * a.y + x2 * a.x; }
        }
        store_bf16_vec<4>(dst + 32 * hf, v);
    }
}
template <int NA>
__device__ __forceinline__ void pp_vec96(const u16* srcA, float rsA, const u16* srcB, u16* dst, const float* gain, int s, float prescale, const float2* tab) {
    float ss = sumsq_bf16<NA / 8>(srcA) * rsA * rsA;
    if (NA < 96) ss += sumsq_bf16<(96 - NA) / 8>(srcB);
    const float rn = rsqrtf(ss * (1.f / 96.f) + EPS) * prescale;
    const float ra = rn * rsA;
#pragma unroll 2
    for (int cch = 0; cch < 8; ++cch) {
        float v[8]; load_bf16_vec<1>(srcA + 8 * cch, v);
#pragma unroll
        for (int i = 0; i < 8; ++i) v[i] = v[i] * ra * gain[8 * cch + i];
        store_bf16_vec<1>(dst + 8 * cch, v);
    }
    float v[32];
    if (NA == 96) { load_bf16_vec<4>(srcA + 64, v);
#pragma unroll
        for (int i = 0; i < 32; ++i) v[i] = v[i] * ra * gain[64 + i]; }
    else { load_bf16_vec<4>(srcB, v);
#pragma unroll
        for (int i = 0; i < 32; ++i) v[i] = v[i] * rn * gain[64 + i]; }
    const float2* t = tab + s * 16;
#pragma unroll
    for (int i = 0; i < 16; ++i) { const float2 a = t[i]; const float x1 = v[i], x2 = v[16 + i]; v[i] = x1 * a.x - x2 * a.y; v[16 + i] = x1 * a.y + x2 * a.x; }
    store_bf16_vec<4>(dst + 64, v);
}

__device__ __forceinline__ void vtrans_tile4(const Ctx& c, const u16* src, int ldsrc, size_t tok0, int tstride, const u16* rs_src  , u16* dst  ) {
    LAS unsigned char* T = c.lds;
    LAS float* RS = (LAS float*)(c.lds + 32768);
    const int tid = c.tid;
    u32x4 w[4];
#pragma unroll
    for (int i = 0; i < 4; ++i) { const int p = i * 64 + (tid >> 3), cc = tid & 7; w[i] = *(const u32x4*)(src + (tok0 + (size_t)p * tstride) * ldsrc + cc * 8); }
    if (rs_src) {
        const int p = tid >> 1, part = tid & 1;
        float s = sumsq_bf16<8>(rs_src + (tok0 + (size_t)p * tstride) * INWP + 1536 + part * 64);
        s += __shfl_xor(s, 1);
        if (part == 0) RS[p] = rsqrtf(s * (1.f / 128.f) + EPS);
        __syncthreads();
#pragma unroll
        for (int i = 0; i < 4; ++i) { const float r = RS[i * 64 + (tid >> 3)];
            w[i].x = cvt_pk_bf16(bf_lo(w[i].x) * r, bf_hi(w[i].x) * r); w[i].y = cvt_pk_bf16(bf_lo(w[i].y) * r, bf_hi(w[i].y) * r);
            w[i].z = cvt_pk_bf16(bf_lo(w[i].z) * r, bf_hi(w[i].z) * r); w[i].w = cvt_pk_bf16(bf_lo(w[i].w) * r, bf_hi(w[i].w) * r); }
    }
#pragma unroll
    for (int i = 0; i < 4; ++i) { const int p = i * 64 + (tid >> 3), cc = tid & 7; *(LAS u32x4*)(T + p * 128 + ((cc ^ ((p >> 3) & 7)) * 16)) = w[i]; }
    __syncthreads();
#pragma unroll
    for (int i = 0; i < 4; ++i) {
        const int d = tid >> 3, pc = (tid & 7) + 8 * i;
        const LAS unsigned char* tp = T + (8 * pc) * 128 + (((d >> 3) ^ (pc & 7)) * 16) + (d & 7) * 2;
        unsigned e[8];
#pragma unroll
        for (int j = 0; j < 8; ++j) e[j] = *(const LAS u16*)(tp + j * 128);
        u32x4 o; o.x = e[0] | (e[1] << 16); o.y = e[2] | (e[3] << 16); o.z = e[4] | (e[5] << 16); o.w = e[6] | (e[7] << 16);
        *(u32x4*)(dst + (size_t)d * 4096 + pc * 8) = o;
    }
    __syncthreads();
}

__device__ __forceinline__ void phase_pp(const Ctx& c, int l) {
    const u16* proj = (const u16*)(c.ws + WS_R1);
    const u16* cbuf = (const u16*)(c.ws + WS_XN);
    const float2* tab = (const float2*)(c.ws + WS_ROPE);
    const float sA = 0.125f * LOG2E, sB = 0.17677669529663687f * LOG2E, sC = 0.10206207261596575f * LOG2E;
    { u16* Kp = (u16*)(c.ws + WS_KA); const float* g = c.p.in[I_AKN] + l * 64;
      for (int j = c.gtid; j < NTOK * 2; j += c.gthreads) { const int T = j >> 1, hh = j & 1, b = T >> 12, s = T & 4095;
        pp_vec64<0, true>(proj + (size_t)T * INWP + 256 + hh * 64, Kp + ((size_t)(b * 2 + hh) * 4096 + s) * 64, g, s, 1.f, tab); } }
    { u16* Kp = (u16*)(c.ws + WS_KB); const float* g = c.p.in[I_BKN] + l * 32;
      for (int j = c.gtid; j < NTOK * 4; j += c.gthreads) { const int T = j >> 2, hh = j & 3, b = T >> 12, s = T & 4095;
        pp_vec64<1, false>(proj + (size_t)T * INWP + 768 + hh * 64, Kp + ((size_t)(b * 4 + hh) * 4096 + s) * 64, g, s, 1.f, tab); } }
    { u16* Kp = (u16*)(c.ws + WS_KD); const float* g = c.p.in[I_DKN] + l * 64;
      for (int j = c.gtid; j < NTOK * 4; j += c.gthreads) { const int T = j >> 2, hh = j & 3, b = T >> 12, s = T & 4095;
        pp_vec64<0, false>(proj + (size_t)T * INWP + 1952 + hh * 64, Kp + ((size_t)(b * 4 + hh) * 4096 + s) * 64, g, s, 1.f, tab); } }
    { u16* Q = (u16*)(c.ws + WS_QC); const float* g = c.p.in[I_CQN] + l * 96;
      for (int j = c.gtid; j < NTOK * 4; j += c.gthreads) { const int T = j >> 2, hh = j & 3, b = T >> 12, s = T & 4095;
        float ssl = sumsq_bf16<8>(proj + (size_t)T * INWP + 1280 + hh * 64);
        ssl += __shfl_xor(ssl, 1); ssl += __shfl_xor(ssl, 2);
        const float rs = rsqrtf(ssl * (1.f / 256.f) + EPS);
        pp_vec96<96>(cbuf + (size_t)T * 1024 + hh * 96, rs, nullptr, Q + ((size_t)(b * 4 + hh) * 4096 + s) * 96, g, s, sC, tab); } }
    { u16* Kp = (u16*)(c.ws + WS_KC); const float* g = c.p.in[I_CKN] + l * 96;
      for (int j = c.gtid; j < NTOK * 4; j += c.gthreads) { const int T = j >> 2, hh = j & 3, b = T >> 12, s = T & 4095;
        float ssl = sumsq_bf16<4>(proj + (size_t)T * INWP + 1536 + hh * 32);
        ssl += __shfl_xor(ssl, 1); ssl += __shfl_xor(ssl, 2);
        const float rs = rsqrtf(ssl * (1.f / 128.f) + EPS);
        pp_vec96<64>(cbuf + (size_t)T * 1024 + 384 + hh * 128, rs, proj + (size_t)T * INWP + 1664, Kp + ((size_t)(b * 4 + hh) * 4096 + s) * 96, g, s, 1.f, tab); } }
    for (int j = blockIdx.x; j < 22 * 8 * 16; j += gridDim.x) {
        const int tile = j & 15, b = (j >> 4) & 7, kind = j >> 7;
        const size_t tb = (size_t)b * 4096;
        const int p0 = tile * 256;
        if (kind < 2) { const int hh = kind; vtrans_tile4(c, proj + 384 + hh * 64, INWP, tb + p0, 1, nullptr, (u16*)(c.ws + WS_VTA) + (size_t)(b * 2 + hh) * 64 * 4096 + p0); }
        else if (kind < 6) { const int hh = kind - 2; vtrans_tile4(c, proj + 1024 + hh * 64, INWP, tb + p0, 1, nullptr, (u16*)(c.ws + WS_VTB) + (size_t)(b * 4 + hh) * 64 * 4096 + p0); }
        else if (kind < 10) { const int hh = kind - 6; vtrans_tile4(c, cbuf + 384 + hh * 128 + 64, 1024, tb + p0, 1, proj, (u16*)(c.ws + WS_VTC) + (size_t)(b * 4 + hh) * 64 * 4096 + p0); }
        else { const int k2 = kind - 10, br = k2 >> 2, hh = k2 & 3; const int dil = br == 0 ? 1 : (br == 1 ? 4 : 16), L = 4096 / dil;
               const int r = p0 / L, j0 = p0 % L;
               vtrans_tile4(c, proj + 2208 + hh * 64, INWP, tb + (size_t)j0 * dil + r, dil, nullptr, (u16*)(c.ws + WS_VTD) + (size_t)((br * 8 + b) * 4 + hh) * 64 * 4096 + p0); }
    }
}

#define AT_BAR() do { asm volatile("s_waitcnt lgkmcnt(0)" ::: "memory"); __builtin_amdgcn_s_barrier(); asm volatile("" ::: "memory"); } while (0)
template <int TYPE>
__device__ __forceinline__ void attn_unit(const Ctx& c, int l, int b, int hh, int qb, int br) {
    constexpr int DQK = TYPE == 2 ? 96 : 64;
    constexpr int CPR = DQK / 8;
    constexpr int KROWB = DQK * 2 + 16;
    constexpr int KTB = 64 * KROWB;
    constexpr int VROWB = 144;
    constexpr int BUFB = KTB + 64 * VROWB;
    constexpr int NPASS = TYPE == 1 ? 2 : 1;
    constexpr int NKK = TYPE == 1 ? 2 : DQK / 16;
    constexpr bool PIPE = TYPE != 1;
    LAS unsigned char* lds = c.lds;
    int tid_ = c.tid; asm volatile("" : "+v"(tid_));
    asm volatile("" : "+s"(l), "+s"(b), "+s"(hh), "+s"(qb), "+s"(br));
    const int tid = tid_, lane = tid & 63, w = __builtin_amdgcn_readfirstlane(tid >> 6), q31 = lane & 31, h = lane >> 5;
    int dil = 1, r = 0, L = 4096, j0 = qb * 256;
    if (TYPE == 3) { dil = br == 0 ? 1 : (br == 1 ? 4 : 16); L = 4096 / dil; const int P0 = qb * 256; r = P0 / L; j0 = P0 % L; }
    const u16 *Qg, *Kg, *Vg;
    const float *gq, *gk; int ng;
    if (TYPE == 0) { Qg = (const u16*)(c.ws + WS_QA) + (size_t)(b * 4 + hh) * 4096 * 64; Kg = (const u16*)(c.ws + WS_KA) + (size_t)(b * 2 + (hh >> 1)) * 4096 * 64;
                     Vg = (const u16*)(c.ws + WS_VTA) + (size_t)(b * 2 + (hh >> 1)) * 64 * 4096; gq = c.p.in[I_AQN] + l * 64; gk = c.p.in[I_AKN] + l * 64; ng = 64; }
    else if (TYPE == 1) { Qg = (const u16*)(c.ws + WS_QB) + (size_t)(b * 4 + hh) * 4096 * 64; Kg = (const u16*)(c.ws + WS_KB) + (size_t)(b * 4 + hh) * 4096 * 64;
                     Vg = (const u16*)(c.ws + WS_VTB) + (size_t)(b * 4 + hh) * 64 * 4096; gq = c.p.in[I_BQN] + l * 32; gk = c.p.in[I_BKN] + l * 32; ng = 32; }
    else if (TYPE == 2) { Qg = (const u16*)(c.ws + WS_QC) + (size_t)(b * 4 + hh) * 4096 * 96; Kg = (const u16*)(c.ws + WS_KC) + (size_t)(b * 4 + hh) * 4096 * 96;
                     Vg = (const u16*)(c.ws + WS_VTC) + (size_t)(b * 4 + hh) * 64 * 4096; gq = c.p.in[I_CQN] + l * 96; gk = c.p.in[I_CKN] + l * 96; ng = 96; }
    else { Qg = (const u16*)(c.ws + WS_QD) + (size_t)(b * 4 + hh) * 4096 * 64; Kg = (const u16*)(c.ws + WS_KD) + (size_t)(b * 4 + hh) * 4096 * 64;
                     Vg = (const u16*)(c.ws + WS_VTD) + (size_t)((br * 8 + b) * 4 + hh) * 64 * 4096 + (size_t)r * L; gq = c.p.in[I_DQN] + l * 64; gk = c.p.in[I_DKN] + l * 64; ng = 64; }
    const float scale = TYPE == 1 ? 0.17677669529663687f : (TYPE == 2 ? 0.10206207261596575f : 0.125f);
    const float Mp = (float)ng * wave_absmax(gq, ng, lane) * wave_absmax(gk, ng, lane) * scale * LOG2E * 1.02f;
    float sl = 0.f;
    if (TYPE == 1) sl = exp2f(-(float)(hh + 1)) * LOG2E;
    if (TYPE == 3) sl = exp2f(-(float)(hh + 5)) * LOG2E * (float)dil;
    int klo = 0, khi = L;
    if (TYPE == 1) { const int W = (int)((2.f * Mp + 50.f) / sl) + 1; klo = j0 - W; khi = j0 + 256 + W; klo = klo < 0 ? 0 : (klo & ~63); khi = khi > L ? L : ((khi + 63) & ~63); }
    if (TYPE == 3) { klo = j0 - 64; khi = j0 + 320; klo = klo < 0 ? 0 : klo; khi = khi > L ? L : khi; }
    const int ntile = (khi - klo) >> 6;
    const int jq = j0 + 32 * w + q31;
    const int pi = (q31 & ~12) | ((q31 & 4) << 1) | ((q31 & 8) >> 1);
    const int vfo = q31 * VROWB + h * 16;
    const int krow0 = tid / CPR, kcc0 = tid % CPR, krow1 = (tid + 512) / CPR, kcc1 = (tid + 512) % CPR;
    const int vd = tid >> 3, vcc = tid & 7;
    f32x16 O[2], Osv[2];
    float lsum = 0.f;
#pragma unroll
    for (int d = 0; d < 2; ++d)
#pragma unroll
        for (int i = 0; i < 16; ++i) Osv[d][i] = 0.f;
#pragma unroll 1
    for (int pass = 0; pass < NPASS; ++pass) {
        const int kfo = pi * KROWB + h * 16 + pass * 64;
        bf16x8 qf[NKK];
        if (TYPE == 2) {
            const u16* qrow = Qg + ((size_t)jq * dil + r) * DQK + h * 8 + pass * 32;
#pragma unroll
            for (int kk = 0; kk < NKK; ++kk) qf[kk] = *(const bf16x8*)(qrow + kk * 16);
        } else {
            const int sq_ = jq * dil + r;
            const u16* qraw = (const u16*)(c.ws + WS_R1) + ((size_t)b * 4096 + sq_) * INWP + (TYPE == 0 ? 0 : (TYPE == 1 ? 512 : 1696)) + hh * 64 + h * 8 + pass * 32;
            float qv[NKK][8];
            float ssq = 0.f;
#pragma unroll
            for (int kk = 0; kk < NKK; ++kk) { load_bf16_vec<1>(qraw + kk * 16, qv[kk]);
#pragma unroll
                for (int j = 0; j < 8; ++j) ssq += qv[kk][j] * qv[kk][j]; }
            ssq += __shfl_xor(ssq, 32);
            const float rnq = rsqrtf(ssq * (1.f / (float)(16 * NKK)) + EPS) * (scale * LOG2E);
#pragma unroll
            for (int kk = 0; kk < NKK; ++kk) { const f32x4 g0 = *(const f32x4*)(gq + kk * 16 + h * 8), g1 = *(const f32x4*)(gq + kk * 16 + h * 8 + 4);
#pragma unroll
                for (int j = 0; j < 4; ++j) { qv[kk][j] *= rnq * g0[j]; qv[kk][4 + j] *= rnq * g1[j]; } }
            if (TYPE == 0) {
                const float2* tab = (const float2*)(c.ws + WS_ROPE);
#pragma unroll
                for (int hf = 0; hf < 2; ++hf) {
                    const float2* t = tab + (hf == 0 ? (sq_ >> 6) : (sq_ & 63)) * 16 + h * 8;
#pragma unroll
                    for (int j = 0; j < 8; ++j) { const float2 a = t[j]; const float x1 = qv[NKK >= 4 ? 2 * hf : 0][j], x2 = qv[NKK >= 4 ? 2 * hf + 1 : 1][j];
                        qv[NKK >= 4 ? 2 * hf : 0][j] = x1 * a.x - x2 * a.y; qv[NKK >= 4 ? 2 * hf + 1 : 1][j] = x1 * a.y + x2 * a.x; }
                }
            }
#pragma unroll
            for (int kk = 0; kk < NKK; ++kk) { u32x4 pw;
                pw.x = cvt_pk_bf16(qv[kk][0], qv[kk][1]); pw.y = cvt_pk_bf16(qv[kk][2], qv[kk][3]); pw.z = cvt_pk_bf16(qv[kk][4], qv[kk][5]); pw.w = cvt_pk_bf16(qv[kk][6], qv[kk][7]);
                qf[kk] = __builtin_bit_cast(bf16x8, pw); }
        }
        lsum = 0.f;
#pragma unroll
        for (int d = 0; d < 2; ++d)
#pragma unroll
            for (int i = 0; i < 16; ++i) O[d][i] = 0.f;
        constexpr int VB0 = 2 * KTB;
        u32x4 kr0, kr1 = {0u, 0u, 0u, 0u}, vr;
#define AT_GLOADK(kp0) do { kr0 = *(const u32x4*)(Kg + ((size_t)((kp0) + krow0) * dil + r) * DQK + kcc0 * 8); \
        if (DQK == 96 && tid < 256) kr1 = *(const u32x4*)(Kg + ((size_t)((kp0) + krow1) * dil + r) * DQK + kcc1 * 8); } while (0)
#define AT_GLOADV(kp0) do { vr = *(const u32x4*)(Vg + (size_t)vd * 4096 + (kp0) + vcc * 8); } while (0)
#define AT_LWRITEK(buf) do { *(LAS u32x4*)(lds + (buf) * KTB + krow0 * KROWB + kcc0 * 16) = kr0; \
        if (DQK == 96 && tid < 256) *(LAS u32x4*)(lds + (buf) * KTB + krow1 * KROWB + kcc1 * 16) = kr1; } while (0)
#define AT_LWRITEV(buf) do { *(LAS u32x4*)(lds + VB0 + (buf) * 64 * VROWB + vd * VROWB + vcc * 16) = vr; } while (0)
#define AT_QK(Sx, kbuf_, kp0_) do { \
        _Pragma("unroll") for (int kb = 0; kb < 2; ++kb) { \
            if (TYPE == 1 || TYPE == 3) { \
                const float tq = (float)(jq - (kp0_) - 8 * h - kb * 32); \
                _Pragma("unroll") for (int i = 0; i < 16; ++i) { \
                    const float dd = fabsf(tq - (float)(16 * (i >> 3) + (i & 7))); \
                    float v_ = -Mp - sl * dd; \
                    if (TYPE == 3) v_ = dd <= 64.f ? v_ : -INFINITY; \
                    Sx[kb][i] = v_; } \
            } else { _Pragma("unroll") for (int i = 0; i < 16; ++i) Sx[kb][i] = -Mp; } } \
        _Pragma("unroll") for (int kk = 0; kk < NKK; ++kk) \
            _Pragma("unroll") for (int kb = 0; kb < 2; ++kb) {     \
                const bf16x8 kf = *(const LAS bf16x8*)(lds + (kbuf_) * KTB + kfo + kb * 32 * KROWB + kk * 32); \
                Sx[kb] = __builtin_amdgcn_mfma_f32_32x32x16_bf16(kf, qf[kk], Sx[kb], 0, 0, 0); } } while (0)
        f32x16 S[2][2];
        const int jw = j0 + 32 * w;
#define AT_ACTIVE(kp0_) (TYPE != 3 || (((kp0_) + 63 >= jw - 64) && ((kp0_) <= jw + 31 + 64)))
        AT_GLOADK(klo); AT_GLOADV(klo); AT_LWRITEK(0); AT_LWRITEV(0);
        if (PIPE && ntile > 1) { AT_GLOADK(klo + 64); AT_LWRITEK(1); }
        AT_BAR();
        if (PIPE) { if (AT_ACTIVE(klo)) AT_QK(S[0], 0, klo);
                    AT_BAR(); }
        for (int t0 = 0; t0 < ntile; t0 += 2) {
#pragma unroll
          for (int half = 0; half < 2; ++half) {
            const int t = t0 + half;
            if (t < ntile) {
            const int kp0 = klo + t * 64;
            if (PIPE ? t + 2 < ntile : t + 1 < ntile) AT_GLOADK(kp0 + (PIPE ? 128 : 64));
            if (t + 1 < ntile) AT_GLOADV(kp0 + 64);
            if (PIPE) { if (t + 1 < ntile && AT_ACTIVE(kp0 + 64)) AT_QK(S[half ^ 1], half ^ 1, kp0 + 64); }
            if (AT_ACTIVE(kp0)) {
                if (!PIPE) AT_QK(S[half], half, kp0);
                bf16x8 pf[4];
#pragma unroll
                for (int kb = 0; kb < 2; ++kb) {
                    float ps = 0.f;
                    float pe[16];
#pragma unroll
                    for (int i = 0; i < 16; ++i) { pe[i] = __builtin_amdgcn_exp2f(S[half][kb][i]); ps += pe[i]; }
                    lsum += ps;
#pragma unroll
                    for (int s2 = 0; s2 < 2; ++s2) {
                        u32x4 pw;
                        pw.x = cvt_pk_bf16(pe[8 * s2 + 0], pe[8 * s2 + 1]); pw.y = cvt_pk_bf16(pe[8 * s2 + 2], pe[8 * s2 + 3]);
                        pw.z = cvt_pk_bf16(pe[8 * s2 + 4], pe[8 * s2 + 5]); pw.w = cvt_pk_bf16(pe[8 * s2 + 6], pe[8 * s2 + 7]);
                        pf[kb * 2 + s2] = __builtin_bit_cast(bf16x8, pw);
                    }
                }
#pragma unroll
                for (int ks = 0; ks < 4; ++ks)
#pragma unroll
                    for (int db = 0; db < 2; ++db) {
                        const bf16x8 vf = *(const LAS bf16x8*)(lds + VB0 + half * 64 * VROWB + vfo + db * 32 * VROWB + ks * 32);
                        O[db] = __builtin_amdgcn_mfma_f32_32x32x16_bf16(vf, pf[ks], O[db], 0, 0, 0);
                    }
            }
            if (PIPE ? t + 2 < ntile : t + 1 < ntile) AT_LWRITEK(PIPE ? half : half ^ 1);
            if (t + 1 < ntile) AT_LWRITEV(half ^ 1);
            AT_BAR();
            }
          }
        }
#undef AT_GLOADK
#undef AT_GLOADV
#undef AT_LWRITEK
#undef AT_LWRITEV
#undef AT_QK
#undef AT_ACTIVE
        if (TYPE == 1 && pass == 0) {
            const float i1 = 1.f / (lsum + __shfl_xor(lsum, 32));
#pragma unroll
            for (int d = 0; d < 2; ++d)
#pragma unroll
                for (int i = 0; i < 16; ++i) Osv[d][i] = O[d][i] * i1;
        }
    }
    const int sq = jq * dil + r;
    const size_t tok = (size_t)b * 4096 + sq;
    const float lt = lsum + __shfl_xor(lsum, 32);
    if (TYPE == 0 || TYPE == 2) {
        const float inv = 1.f / lt;
        u16* op = (u16*)(c.ws + WS_MIX) + tok * 1024 + (TYPE == 0 ? 0 : 512) + hh * 64 + 4 * h;
#pragma unroll
        for (int db = 0; db < 2; ++db)
#pragma unroll
            for (int g = 0; g < 4; ++g) {
                u32x2 wv; wv.x = cvt_pk_bf16(O[db][4 * g] * inv, O[db][4 * g + 1] * inv); wv.y = cvt_pk_bf16(O[db][4 * g + 2] * inv, O[db][4 * g + 3] * inv);
                *(u32x2*)(op + db * 32 + 8 * g) = wv;
            }
    } else if (TYPE == 1) {
        float pr = lane < 32 ? c.p.in[I_LQ1][l * 32 + lane] * c.p.in[I_LK1][l * 32 + lane] : c.p.in[I_LQ2][l * 32 + lane - 32] * c.p.in[I_LK2][l * 32 + lane - 32];
#pragma unroll
        for (int o = 1; o < 32; o <<= 1) pr += __shfl_xor(pr, o);
        const float s1 = __shfl(pr, 0), s2 = __shfl(pr, 32);
        const float lam_init = 0.8f - 0.6f * expf(-0.3f * (float)l);
        const float lam = expf(s1) - expf(s2) + lam_init;
        const float i2 = lam / lt;
        float ss = 0.f;
#pragma unroll
        for (int db = 0; db < 2; ++db)
#pragma unroll
            for (int i = 0; i < 16; ++i) { const float o = Osv[db][i] - O[db][i] * i2; O[db][i] = o; ss += o * o; }
        ss += __shfl_xor(ss, 32);
        const float rn = rsqrtf(ss * (1.f / 64.f) + EPS) * (1.f - lam_init);
        const float* gs = c.p.in[I_BSUB] + l * 64 + 4 * h;
        u16* op = (u16*)(c.ws + WS_MIX) + tok * 1024 + 256 + hh * 64 + 4 * h;
#pragma unroll
        for (int db = 0; db < 2; ++db)
#pragma unroll
            for (int g = 0; g < 4; ++g) {
                const f32x4 gv = *(const f32x4*)(gs + db * 32 + 8 * g);
                u32x2 wv; wv.x = cvt_pk_bf16(O[db][4 * g] * rn * gv[0], O[db][4 * g + 1] * rn * gv[1]); wv.y = cvt_pk_bf16(O[db][4 * g + 2] * rn * gv[2], O[db][4 * g + 3] * rn * gv[3]);
                *(u32x2*)(op + db * 32 + 8 * g) = wv;
            }
    } else {
        const float inv = 1.f / lt;
        u16* op = (u16*)(c.ws + dpart_off(br)) + tok * 256 + hh * 64 + 4 * h;
#pragma unroll
        for (int db = 0; db < 2; ++db)
#pragma unroll
            for (int g = 0; g < 4; ++g) {
                u32x2 wv; wv.x = cvt_pk_bf16(O[db][4 * g] * inv, O[db][4 * g + 1] * inv); wv.y = cvt_pk_bf16(O[db][4 * g + 2] * inv, O[db][4 * g + 3] * inv);
                *(u32x2*)(op + db * 32 + 8 * g) = wv;
            }
        if (h == 0) ((float*)(c.ws + WS_LD))[((size_t)br * NTOK + tok) * 4 + hh] = lt;
    }
}

__device__ __forceinline__ void phase_attn(const Ctx& c, int l) {
    for (int u = blockIdx.x; u < 1536; u += gridDim.x) {
        const int type = u >> 9;
        const int v = u & 511;
        const int k = v >> 8, i = v & 255, xcd = i & 7, slot = i >> 3;
        const int pair = k * 16 + xcd * 2 + (slot >> 4), b = pair >> 2, qb = slot & 15;
        int hh = pair & 3;
        if (type == 1 && k == 1) hh = 3 - hh;
        if (type == 0) attn_unit<0>(c, l, b, hh, qb, 0);
        else if (type == 1) attn_unit<1>(c, l, b, hh, qb, 0);
        else attn_unit<2>(c, l, b, hh, qb, 0);
    }
    unsigned* ticket = (unsigned*)(c.ws + WS_BAR) + TICKET_WORD0 + 64 * l;
    volatile LAS unsigned* tk = (volatile LAS unsigned*)(c.lds + 131072 + 16);
    for (;;) {
        __syncthreads();
        if (threadIdx.x == 0) tk[0] = __hip_atomic_fetch_add(ticket, 1u, __ATOMIC_RELAXED, __HIP_MEMORY_SCOPE_AGENT);
        __syncthreads();
        const int v = (int)tk[0];
        if (v >= 1536) break;
        const int br = v >> 9, w_ = v & 511;
        const int b = w_ >> 6, hh = (w_ >> 4) & 3, qb = w_ & 15;
        attn_unit<3>(c, l, b, hh, qb, br);
    }
}

__device__ __forceinline__ void phase_dmerge(const Ctx& c) {
    const float* ld = (const float*)(c.ws + WS_LD); u16* mix = (u16*)(c.ws + WS_MIX);
    for (int j = c.gtid; j < NTOK * 32; j += c.gthreads) {
        const int tok = j >> 5, ch = j & 31, hh = ch >> 3;
        float acc[8]; float lt = 0.f;
#pragma unroll
        for (int i = 0; i < 8; ++i) acc[i] = 0.f;
#pragma unroll
        for (int br = 0; br < 3; ++br) {
            const float lb = ld[((size_t)br * NTOK + tok) * 4 + hh]; lt += lb;
            float v[8]; load_bf16_vec<1>((const u16*)(c.ws + dpart_off(br)) + (size_t)tok * 256 + ch * 8, v);
#pragma unroll
            for (int i = 0; i < 8; ++i) acc[i] += lb * v[i];
        }
        const float inv = 1.f / lt;
#pragma unroll
        for (int i = 0; i < 8; ++i) acc[i] *= inv;
        store_bf16_vec<1>(mix + (size_t)tok * 1024 + 768 + ch * 8, acc);
    }
}

__device__ __forceinline__ void phase_ffn_fixup(const Ctx& c, int l) {
    const u16* hb = (const u16*)(c.ws + WS_HB); u16* act = (u16*)(c.ws + WS_ACT);
    const float* cw = c.p.in[I_CONVW] + (size_t)l * 3 * 5632; const float* cb = c.p.in[I_CONVB] + (size_t)l * 5632;
    for (int j = c.gtid; j < 512 * 2 * 352; j += c.gthreads) {
        const int ch = j % 352, e = (j / 352) & 1, blk = j / 704;
        const int row = blk * 64 + (e ? 63 : 0), s = row & 4095, c0 = ch * 8;
        const int hc = 256 * (c0 >> 7) + (c0 & 127);
        const u16* yu = e ? hb + ((size_t)blk * 4 + 2) * 5632 : hb + ((size_t)(blk - 1) * 4 + 3) * 5632;
        const u16* yc = hb + ((size_t)blk * 4 + (e ? 3 : 0)) * 5632;
        const u16* yd = e ? hb + ((size_t)(blk + 1) * 4 + 0) * 5632 : hb + ((size_t)blk * 4 + 1) * 5632;
        const bool hasu = e || s != 0, hasd = !e || s != 4095;
        float gu[8], gc[8], gd[8], vu[8], vc[8], vd[8];
        load_bf16_vec<1>(yc + hc, gc); load_bf16_vec<1>(yc + hc + 128, vc);
        if (hasu) { load_bf16_vec<1>(yu + hc, gu); load_bf16_vec<1>(yu + hc + 128, vu); }
        else {
#pragma unroll
            for (int i = 0; i < 8; ++i) { gu[i] = 0.f; vu[i] = 0.f; } }
        if (hasd) { load_bf16_vec<1>(yd + hc, gd); load_bf16_vec<1>(yd + hc + 128, vd); }
        else {
#pragma unroll
            for (int i = 0; i < 8; ++i) { gd[i] = 0.f; vd[i] = 0.f; } }
        float o[8];
#pragma unroll
        for (int i = 0; i < 8; ++i) {
            const float ug = gu[i] * cw[c0 + i] + gc[i] * cw[5632 + c0 + i] + gd[i] * cw[2 * 5632 + c0 + i] + cb[c0 + i];
            const float uv = vu[i] * cw[DFF + c0 + i] + vc[i] * cw[5632 + DFF + c0 + i] + vd[i] * cw[2 * 5632 + DFF + c0 + i] + cb[DFF + c0 + i];
            o[i] = ug / (1.f + __expf(-ug)) * uv;
        }
        store_bf16_vec<1>(act + (size_t)row * DFF + c0, o);
    }
}

#define XB_TMO      128
#define XB_XCNT(j)  (256  + 64 * (j))
#define XB_XSUB(j)  (1280 + 64 * (j))
#define XB_XGEN(j)  (2304 + 64 * (j))
#define XB_TOP      3328
#define XB_TOPGEN   3392
#define XCD_BAR_WORDS 3456
#define XB_SPIN_CAP (1u << 18)

__device__ __forceinline__ unsigned xb_ld(unsigned* p)              { return __hip_atomic_load(p, __ATOMIC_RELAXED, __HIP_MEMORY_SCOPE_AGENT); }
__device__ __forceinline__ unsigned xb_add(unsigned* p, unsigned v) { return __hip_atomic_fetch_add(p, v, __ATOMIC_RELAXED, __HIP_MEMORY_SCOPE_AGENT); }
__device__ __forceinline__ unsigned xb_xcc_id() { return (unsigned)__builtin_amdgcn_s_getreg((3 << 11) | 20) & 0xFu; }
#define XB_SPIN(cond, bar) do { unsigned _sp = 0; while (cond) { __builtin_amdgcn_s_sleep(1); \
    if ((++_sp & 255u) == 0u) { if (xb_ld(&(bar)[XB_TMO])) break; if (_sp > XB_SPIN_CAP) { atomicAdd(&(bar)[XB_TMO], 1u); break; } } } } while (0)

struct XcdBarrier {
    unsigned* bar; unsigned x;
    volatile LAS unsigned* st;
};

__device__ __forceinline__ XcdBarrier xcd_barrier_post(unsigned* bar, volatile LAS unsigned* st) {
    XcdBarrier b; b.bar = bar; b.x = xb_xcc_id(); b.st = st;
    if (threadIdx.x == 0) (void)xb_add(&bar[XB_XCNT(b.x)], 1u);
    return b;
}
__device__ __forceinline__ void xcd_barrier_complete(unsigned* bar, unsigned x, unsigned& nloc, unsigned& nx) {
    const unsigned G = gridDim.x * gridDim.y * gridDim.z;
    unsigned sum, cnt, mine, sp = 0u;
    for (;;) {
        sum = 0u; cnt = 0u; mine = 0u;
#pragma unroll
        for (unsigned j = 0; j < 16; ++j) { const unsigned c = xb_ld(&bar[XB_XCNT(j)]); sum += c; cnt += (c > 0u) ? 1u : 0u; mine = (j == x) ? c : mine; }
        if (sum == G) break;
        __builtin_amdgcn_s_sleep(1);
        if ((++sp & 255u) == 0u) { if (xb_ld(&bar[XB_TMO])) break; if (sp > XB_SPIN_CAP) { atomicAdd(&bar[XB_TMO], 1u); break; } }
    }
    nloc = mine > 0u ? mine : 1u; nx = cnt > 0u ? cnt : 1u;
}

__device__ __forceinline__ void xcd_barrier(const XcdBarrier& b) {
    asm volatile("s_waitcnt vmcnt(0)" ::: "memory");
    __syncthreads();
    if (threadIdx.x == 0) {
        unsigned* bar = b.bar;
        __builtin_amdgcn_s_waitcnt(0);
        unsigned nloc = b.st[0], nx = b.st[1];
        if (nloc == 0u) { xcd_barrier_complete(bar, b.x, nloc, nx); b.st[0] = nloc; b.st[1] = nx; }
        const unsigned old = xb_add(&bar[XB_XSUB(b.x)], 1u);
        const unsigned gen = old / nloc;
        if (old + 1u == (gen + 1u) * nloc) {
            __builtin_amdgcn_fence(__ATOMIC_RELEASE, "agent");
            asm volatile("s_waitcnt vmcnt(0)" ::: "memory");
            const unsigned og = xb_add(&bar[XB_TOP], 1u);
            const unsigned tg = og / nx;
            if (og + 1u == (tg + 1u) * nx) xb_add(&bar[XB_TOPGEN], 1u);
            else XB_SPIN(xb_ld(&bar[XB_TOPGEN]) == tg, bar);
            __builtin_amdgcn_fence(__ATOMIC_ACQUIRE, "agent");
            xb_add(&bar[XB_XGEN(b.x)], 1u);
            asm volatile("s_waitcnt vmcnt(0)" ::: "memory");
        } else {
            XB_SPIN(xb_ld(&bar[XB_XGEN(b.x)]) == gen, bar);
            __builtin_amdgcn_fence(__ATOMIC_ACQUIRE, "agent");
            asm volatile("s_waitcnt vmcnt(0)" ::: "memory");
        }
    }
    __syncthreads();
}


#define GSYNC() do { asm volatile("s_waitcnt vmcnt(0) lgkmcnt(0)" ::: "memory"); grid.sync(); asm volatile("" ::: "memory"); } while (0)
static_assert(TICKET_WORD0 == XCD_BAR_WORDS, "ticket words follow the barrier words");
#define XSYNC() do { asm volatile("s_waitcnt lgkmcnt(0)" ::: "memory"); xcd_barrier(xbar); asm volatile("" ::: "memory"); } while (0)
#define LAUNDER(c) do { int t_ = threadIdx.x; asm volatile("" : "+v"(t_)); (c).tid = t_; (c).lane = t_ & 63; (c).wave = __builtin_amdgcn_readfirstlane(t_ >> 6); \
        (c).gtid = blockIdx.x * NTHR + t_; (c).gwave = blockIdx.x * 8 + (c).wave; } while (0)
__global__ void __launch_bounds__(NTHR) fwd_kernel(Params p) {
    extern __shared__ __attribute__((aligned(16))) unsigned char lds_raw[];
    cg::grid_group grid = cg::this_grid();
    Ctx c;
    c.p = p; c.ws = p.ws; c.lds = (LAS unsigned char*)lds_raw;
    c.tid = threadIdx.x; c.lane = c.tid & 63; c.wave = __builtin_amdgcn_readfirstlane(c.tid >> 6);
    c.gtid = blockIdx.x * NTHR + c.tid; c.gthreads = gridDim.x * NTHR; c.gwave = blockIdx.x * 8 + c.wave; c.gwaves = gridDim.x * 8;
    u16* xn = (u16*)(p.ws + WS_XN);
    u16* proj = (u16*)(p.ws + WS_R1);
    volatile LAS unsigned* xst = (volatile LAS unsigned*)(c.lds + 131072);
    if (c.tid == 0) { xst[0] = 0u; xst[1] = 0u; }
    __syncthreads();
    const XcdBarrier xbar = xcd_barrier_post((unsigned*)(p.ws + WS_BAR), xst);
    GSYNC();
    for (int l = 0; l < DEPTH; ++l) {
        const float* xcur = l == 0 ? p.in[I_X] : p.out;
        LAUNDER(c);
        if (l == 0) phase_rope_table(c);
        LAUNDER(c);
        phase_wconv(c, l);
        LAUNDER(c);
        phase_rmsnorm(c, xcur, p.in[I_N1G] + l * 1024, xn);
        XSYNC();
        LAUNDER(c);
        g8::gemm_phase(c.lds, c.tid, xn, 1024, (const u16*)(p.ws + WS_BT_IN), 1024, NTOK / 256, INWP / 256, g8::EpiBf16{proj, INWP});
        XSYNC();
        LAUNDER(c);
        g8::gemm_phase(c.lds, c.tid, proj + 1280, INWP, (const u16*)(p.ws + WS_BT_MLA), 512, NTOK / 256, 4, g8::EpiBf16{xn, 1024});
        XSYNC();
        LAUNDER(c);
        phase_pp(c, l);
        XSYNC();
        LAUNDER(c);
        phase_attn(c, l);
        XSYNC();
        LAUNDER(c);
        phase_dmerge(c);
        XSYNC();
        LAUNDER(c);
        g8::gemm_phase(c.lds, c.tid, (const u16*)(p.ws + WS_MIX), 1024, (const u16*)(p.ws + WS_BT_OUT), 1024, NTOK / 256, 4, g8::EpiRes{xcur, p.out});
        XSYNC();
        LAUNDER(c);
        phase_rmsnorm(c, p.out, p.in[I_N2G] + l * 1024, xn);
        XSYNC();
        LAUNDER(c);
        g8::gemm_phase(c.lds, c.tid, xn, 1024, (const u16*)(p.ws + WS_BT_UP), 1024, NTOK / 256, 22,
                       g8::EpiConv{(u16*)(p.ws + WS_ACT), (u16*)(p.ws + WS_HB), p.in[I_CONVW] + (size_t)l * 3 * 5632, p.in[I_CONVB] + (size_t)l * 5632});
        XSYNC();
        LAUNDER(c);
        phase_ffn_fixup(c, l);
        XSYNC();
        LAUNDER(c);
        g8::gemm_phase(c.lds, c.tid, (const u16*)(p.ws + WS_ACT), DFF, (const u16*)(p.ws + WS_BT_DN), DFF, NTOK / 256, 4, g8::EpiRes{p.out, p.out});
        XSYNC();
    }
}

extern "C" void kernel_launch(void* const* d_in, const int* in_sizes, int n_in, void* d_out, int out_size, void* d_ws, size_t ws_size,
                              hipStream_t stream) {
    static int grid_blocks = 0;
    if (!grid_blocks) {
        int dev = 0, cus = 0, per_cu = 0;
        (void)hipGetDevice(&dev);
        (void)hipDeviceGetAttribute(&cus, hipDeviceAttributeMultiprocessorCount, dev);
        (void)hipFuncSetAttribute((const void*)fwd_kernel, hipFuncAttributeMaxDynamicSharedMemorySize, LDS_BYTES);
        (void)hipOccupancyMaxActiveBlocksPerMultiprocessor(&per_cu, (const void*)fwd_kernel, NTHR, LDS_BYTES);
        if (per_cu < 1) per_cu = 1;
        grid_blocks = cus * per_cu;
        if (ws_size < WS_END || n_in != 26) fprintf(stderr, "kernel_launch: unexpected ws_size %zu (need %zu) or n_in %d\n", ws_size, (size_t)WS_END, n_in);
    }
    (void)hipMemsetAsync((unsigned char*)d_ws + WS_BAR, 0, (XCD_BAR_WORDS + 64 * DEPTH) * sizeof(unsigned), stream);
    Params p{};
    for (int i = 0; i < 26 && i < n_in; ++i) p.in[i] = (const float*)d_in[i];
    p.out = (float*)d_out;
    p.ws = (unsigned char*)d_ws;
    void* args[] = {&p};
    hipError_t e = hipLaunchCooperativeKernel((const void*)fwd_kernel, dim3(grid_blocks), dim3(NTHR), args, LDS_BYTES, stream);
    if (e != hipSuccess) fprintf(stderr, "cooperative launch failed: %s (grid %d)\n", hipGetErrorString(e), grid_blocks);
}
```

```cpp
#include <hip/hip_runtime.h>
#include <hip/hip_cooperative_groups.h>
#include <cstdio>
#include <cstdint>
namespace cg = cooperative_groups;

#define LAS __attribute__((address_space(3)))
typedef unsigned short u16;
typedef short bf16x8 __attribute__((ext_vector_type(8)));
typedef float f32x4 __attribute__((ext_vector_type(4)));
typedef float f32x16 __attribute__((ext_vector_type(16)));
typedef unsigned u32x4 __attribute__((ext_vector_type(4)));
typedef unsigned u32x2 __attribute__((ext_vector_type(2)));

constexpr int NTOK = 32768, SEQ = 4096, NB = 8, DM = 1024, DEPTH = 4;
constexpr int INW = 2464, INWP = 2560, DFF = 2816;
constexpr float EPS = 1e-6f;
constexpr float LOG2E = 1.4426950408889634f;
constexpr int LDS_BYTES = 131072 + 64;
constexpr int NTHR = 512;

enum { I_X = 0, I_N1G, I_WIN, I_AQN, I_AKN, I_BQN, I_BKN, I_LQ1, I_LK1, I_LQ2, I_LK2, I_BSUB, I_CQAG, I_CKVAG, I_WQB, I_WKVB, I_CQN, I_CKN,
       I_DQN, I_DKN, I_WOUT, I_N2G, I_WUP, I_CONVW, I_CONVB, I_WDOWN };

constexpr size_t WS_BT_IN = 0;
constexpr size_t WS_BT_MLA = WS_BT_IN + (size_t)INWP * 1024 * 2;
constexpr size_t WS_BT_OUT = WS_BT_MLA + (size_t)1024 * 512 * 2;
constexpr size_t WS_BT_UP = WS_BT_OUT + (size_t)1024 * 1024 * 2;
constexpr size_t WS_BT_DN = WS_BT_UP + (size_t)5632 * 1024 * 2;
constexpr size_t WS_ROPE = WS_BT_DN + (size_t)1024 * 2816 * 2;
constexpr size_t WS_LD = WS_ROPE + (size_t)4096 * 16 * 8;
constexpr size_t WS_XN = WS_LD + (size_t)3 * NTOK * 4 * 4;
constexpr size_t WS_R1 = WS_XN + (size_t)NTOK * 1024 * 2;
constexpr size_t WS_MIX = WS_XN;
constexpr size_t WS_QKV = WS_R1 + (size_t)NTOK * INWP * 2;
constexpr size_t QKV_TOK = (size_t)NTOK * 2;
constexpr size_t WS_QA = WS_QKV;
constexpr size_t WS_KA = WS_QA + 256 * QKV_TOK;
constexpr size_t WS_VTA = WS_KA + 128 * QKV_TOK;
constexpr size_t WS_QB = WS_VTA + 128 * QKV_TOK;
constexpr size_t WS_KB = WS_QB + 256 * QKV_TOK;
constexpr size_t WS_VTB = WS_KB + 256 * QKV_TOK;
constexpr size_t WS_QC = WS_VTB + 256 * QKV_TOK;
constexpr size_t WS_KC = WS_QC + 384 * QKV_TOK;
constexpr size_t WS_VTC = WS_KC + 384 * QKV_TOK;
constexpr size_t WS_QD = WS_VTC + 256 * QKV_TOK;
constexpr size_t WS_KD = WS_QD + 256 * QKV_TOK;
constexpr size_t WS_VTD = WS_KD + 256 * QKV_TOK;
constexpr size_t WS_END = WS_VTD + 768 * QKV_TOK;
constexpr size_t WS_ACT = WS_R1;
constexpr size_t WS_HB = WS_ACT + (size_t)NTOK * 2816 * 2;
static_assert(WS_HB + (size_t)512 * 4 * 5632 * 2 <= WS_END, "ffn overlay");
static_assert(WS_END <= (size_t)536870912, "workspace");

constexpr int TICKET_WORD0 = 3456;
constexpr size_t WS_BAR = WS_END;
__host__ __device__ constexpr size_t dpart_off(int br) { return br == 0 ? WS_QA : (br == 1 ? WS_QB : WS_QD); }
struct Params {
    const float* in[26];
    float* out;
    unsigned char* ws;
};

typedef __bf16 bf16x2_t __attribute__((ext_vector_type(2)));
typedef float f32x2_t __attribute__((ext_vector_type(2)));
__device__ __forceinline__ unsigned cvt_pk_bf16(float lo, float hi) { f32x2_t v = {lo, hi}; bf16x2_t b = __builtin_convertvector(v, bf16x2_t); return __builtin_bit_cast(unsigned, b); }
__device__ __forceinline__ float bf_lo(unsigned w) { return __uint_as_float(w << 16); }
__device__ __forceinline__ float bf_hi(unsigned w) { return __uint_as_float(w & 0xffff0000u); }
__device__ __forceinline__ float wave_sum(float v) {
#pragma unroll
    for (int o = 1; o < 64; o <<= 1) v += __shfl_xor(v, o);
    return v;
}
__device__ __forceinline__ float wave_max(float v) {
#pragma unroll
    for (int o = 1; o < 64; o <<= 1) v = fmaxf(v, __shfl_xor(v, o));
    return v;
}
__device__ __forceinline__ float wave_absmax(const float* g, int n, int lane) {
    float v = lane < n ? fabsf(g[lane]) : 0.f;
    if (lane + 64 < n) v = fmaxf(v, fabsf(g[lane + 64]));
    return wave_max(v);
}
template <int N8> __device__ __forceinline__ void load_bf16_vec(const u16* src, float* v) {
#pragma unroll
    for (int c = 0; c < N8; ++c) {
        const u32x4 w = *(const u32x4*)(src + 8 * c);
        v[8 * c + 0] = bf_lo(w.x); v[8 * c + 1] = bf_hi(w.x); v[8 * c + 2] = bf_lo(w.y); v[8 * c + 3] = bf_hi(w.y);
        v[8 * c + 4] = bf_lo(w.z); v[8 * c + 5] = bf_hi(w.z); v[8 * c + 6] = bf_lo(w.w); v[8 * c + 7] = bf_hi(w.w);
    }
}
template <int N8> __device__ __forceinline__ void store_bf16_vec(u16* dst, const float* v) {
#pragma unroll
    for (int c = 0; c < N8; ++c) {
        u32x4 w;
        w.x = cvt_pk_bf16(v[8 * c + 0], v[8 * c + 1]); w.y = cvt_pk_bf16(v[8 * c + 2], v[8 * c + 3]);
        w.z = cvt_pk_bf16(v[8 * c + 4], v[8 * c + 5]); w.w = cvt_pk_bf16(v[8 * c + 6], v[8 * c + 7]);
        *(u32x4*)(dst + 8 * c) = w;
    }
}
template <int N8> __device__ __forceinline__ float sumsq_bf16(const u16* src) {
    float s = 0.f;
#pragma unroll
    for (int c = 0; c < N8; ++c) {
        const u32x4 w = *(const u32x4*)(src + 8 * c);
        float a;
        a = bf_lo(w.x); s += a * a; a = bf_hi(w.x); s += a * a; a = bf_lo(w.y); s += a * a; a = bf_hi(w.y); s += a * a;
        a = bf_lo(w.z); s += a * a; a = bf_hi(w.z); s += a * a; a = bf_lo(w.w); s += a * a; a = bf_hi(w.w); s += a * a;
    }
    return s;
}

namespace g8 {
constexpr int BM = 256, BK = 64, HALF = 128, HTB = HALF * BK * 2, NXCD = 8, WGM = 8;
__device__ __forceinline__ int lds_byte(int r, int c) { const int st = (r >> 4) * 2 + (c >> 5), rr = r & 15, cc = c & 31, ob = rr * 64 + cc * 2; return st * 1024 + (ob ^ (((ob >> 9) & 1) << 5)); }
__device__ __forceinline__ void stage_rc(int b, int& R, int& C) { const int st = b / 1024, sb = b % 1024, swz = sb ^ (((sb >> 9) & 1) << 5); R = (st >> 1) * 16 + swz / 64; C = (st & 1) * 32 + (swz % 64) / 2; }

__device__ __forceinline__ int perm32(int rho) { const int n = rho >> 4, i = rho & 15; return 8 * (i >> 2) + 4 * n + (i & 3); }
__device__ __forceinline__ bool unit_at(int i, int G, int c, int nM, int nN, int& pm, int& pn) {
    const int nwg = nM * nN; const long Lx = (long)i * G + c; if (Lx >= nwg) return false;
    int wgid = (int)Lx; { const int q = nwg / NXCD, r = nwg % NXCD, xcd = wgid % NXCD, off = wgid / NXCD; wgid = (xcd < r ? xcd * (q + 1) : r * (q + 1) + (xcd - r) * q) + off; }
    const int nig = WGM * nN, gid = wgid / nig, fm = gid * WGM, gsz = (nM - fm) < WGM ? (nM - fm) : WGM;
    pm = fm + ((wgid % nig) % gsz); pn = (wgid % nig) / gsz; return true;
}

struct EpiBf16 {
    static constexpr bool PERM = true;
    u16* O; int ldc;
    __device__ __forceinline__ void operator()(const f32x4 (&acc)[2][2][4][2], int brow, int bcol, int wr, int wc, int fr, int fq) const {
#pragma unroll
        for (int ai = 0; ai < 2; ++ai)
#pragma unroll
            for (int m = 0; m < 4; ++m) {
                u16* rowp = O + (size_t)(brow + ai * HALF + wr * 64 + m * 16 + fr) * ldc + bcol + wc * 32 + 8 * fq;
#pragma unroll
                for (int bj = 0; bj < 2; ++bj) {
                    const f32x4 v0 = acc[ai][bj][m][0], v1 = acc[ai][bj][m][1];
                    u32x4 w; w.x = cvt_pk_bf16(v0[0], v0[1]); w.y = cvt_pk_bf16(v0[2], v0[3]); w.z = cvt_pk_bf16(v1[0], v1[1]); w.w = cvt_pk_bf16(v1[2], v1[3]);
                    *(u32x4*)(rowp + bj * HALF) = w;
                }
            }
    }
};
struct EpiRes {
    static constexpr bool PERM = false;
    const float* xin; float* xout;
    __device__ __forceinline__ void operator()(const f32x4 (&acc)[2][2][4][2], int brow, int bcol, int wr, int wc, int fr, int fq) const {
#pragma unroll
        for (int ai = 0; ai < 2; ++ai)
#pragma unroll
            for (int m = 0; m < 4; ++m) {
                const size_t off = (size_t)(brow + ai * HALF + wr * 64 + m * 16 + fr) * 1024 + bcol + wc * 32 + 4 * fq;
#pragma unroll
                for (int bj = 0; bj < 2; ++bj)
#pragma unroll
                    for (int n = 0; n < 2; ++n) {
                        const f32x4 b = *(const f32x4*)(xin + off + bj * HALF + n * 16);
                        *(f32x4*)(xout + off + bj * HALF + n * 16) = b + acc[ai][bj][m][n];
                    }
            }
    }
};

__device__ __forceinline__ float dpp_from_prev(float v) { return __int_as_float(__builtin_amdgcn_update_dpp(0, __float_as_int(v), 0x121  , 0xf, 0xf, false)); }
__device__ __forceinline__ float dpp_from_next(float v) { return __int_as_float(__builtin_amdgcn_update_dpp(0, __float_as_int(v), 0x12F  , 0xf, 0xf, false)); }
struct EpiConv {
    static constexpr bool PERM = false;
    u16* act; u16* hb; const float* cw; const float* cb;
    __device__ __forceinline__ void operator()(const f32x4 (&acc)[2][2][4][2], int brow, int bcol, int wr, int wc, int fr, int fq) const {
        const int lane = fq * 16 + fr, lup = fq * 16 + ((fr + 15) & 15), ldn = fq * 16 + ((fr + 1) & 15);
        const int pn = bcol >> 8;
#pragma unroll
        for (int n = 0; n < 2; ++n) {
            const int cg = 128 * pn + wc * 32 + n * 16 + 4 * fq;
            const f32x4 w0g = *(const f32x4*)(cw + cg), w1g = *(const f32x4*)(cw + 5632 + cg), w2g = *(const f32x4*)(cw + 2 * 5632 + cg), bg = *(const f32x4*)(cb + cg);
            const f32x4 w0v = *(const f32x4*)(cw + DFF + cg), w1v = *(const f32x4*)(cw + 5632 + DFF + cg), w2v = *(const f32x4*)(cw + 2 * 5632 + DFF + cg), bv = *(const f32x4*)(cb + DFF + cg);
#pragma unroll
            for (int ai = 0; ai < 2; ++ai) {
                const int rblk = brow + ai * HALF + wr * 64;
                f32x4 Rgp, Rvp, Lgc, Lvc;
#pragma unroll
                for (int j = 0; j < 4; ++j) { Lgc[j] = dpp_from_next(acc[ai][0][0][n][j]); Lvc[j] = dpp_from_next(acc[ai][1][0][n][j]); Rgp[j] = 0.f; Rvp[j] = 0.f; }
#pragma unroll
                for (int m = 0; m < 4; ++m) {
                    const f32x4 G = acc[ai][0][m][n], V = acc[ai][1][m][n];
                    f32x4 Rgc, Rvc, Lgn = Lgc, Lvn = Lvc;
#pragma unroll
                    for (int j = 0; j < 4; ++j) { Rgc[j] = dpp_from_prev(G[j]); Rvc[j] = dpp_from_prev(V[j]); }
                    if (m < 3) {
#pragma unroll
                        for (int j = 0; j < 4; ++j) { Lgn[j] = dpp_from_next(acc[ai][0][m < 3 ? m + 1 : 3][n][j]); Lvn[j] = dpp_from_next(acc[ai][1][m < 3 ? m + 1 : 3][n][j]); }
                    }
                    const f32x4 upg = fr > 0 ? Rgc : Rgp, upv = fr > 0 ? Rvc : Rvp;
                    const f32x4 dng = fr < 15 ? Lgc : Lgn, dnv = fr < 15 ? Lvc : Lvn;
                    const f32x4 ug = upg * w0g + G * w1g + dng * w2g + bg;
                    const f32x4 uv = upv * w0v + V * w1v + dnv * w2v + bv;
                    f32x4 o;
#pragma unroll
                    for (int j = 0; j < 4; ++j) o[j] = ug[j] * __builtin_amdgcn_rcpf(1.f + __expf(-ug[j])) * uv[j];
                    const int row = rblk + m * 16 + fr;
                    const bool seam = (m == 0 && fr == 0) || (m == 3 && fr == 15);
                    if (!seam) { u32x2 w; w.x = cvt_pk_bf16(o[0], o[1]); w.y = cvt_pk_bf16(o[2], o[3]); *(u32x2*)(act + (size_t)row * DFF + cg) = w; }
                    if ((m == 0 && fr < 2) || (m == 3 && fr > 13)) {
                        const int which = m == 0 ? fr : fr - 12;
                        u16* hp = hb + ((size_t)(row >> 6) * 4 + which) * 5632 + bcol + wc * 32 + n * 16 + 4 * fq;
                        u32x2 wg, wv; wg.x = cvt_pk_bf16(G[0], G[1]); wg.y = cvt_pk_bf16(G[2], G[3]); wv.x = cvt_pk_bf16(V[0], V[1]); wv.y = cvt_pk_bf16(V[2], V[3]);
                        *(u32x2*)hp = wg; *(u32x2*)(hp + HALF) = wv;
                    }
                    Rgp = Rgc; Rvp = Rvc; Lgc = Lgn; Lvc = Lvn;
                }
                asm volatile("" ::: "memory");
            }
        }
        (void)lane;
    }
};

template <class Epi>
__device__ __forceinline__ void gemm_phase(LAS unsigned char* lds, int tid_in, const u16* A, int lda, const u16* Bt, int K, int nM, int nN, const Epi& E) {
    const int tid = tid_in, wid = __builtin_amdgcn_readfirstlane(tid >> 6), lane = tid & 63, wr = wid >> 2, wc = wid & 3, fr = lane & 15, fq = lane >> 4;
    const int nt = K / BK;
    unsigned offA[2], offB[2];
#pragma unroll
    for (int i = 0; i < 2; ++i) { int R, C; stage_rc(tid * 16 + i * 8192, R, C); const int Rb = Epi::PERM ? ((R & ~31) + perm32(R & 31)) : R; offA[i] = (unsigned)(R * lda + C); offB[i] = (unsigned)(Rb * K + C); }
    const unsigned ldsw = (unsigned)wid * 1024u;
    const int aoff = lds_byte(wr * 64 + fr, fq * 8), boff = lds_byte(wc * 32 + fr, fq * 8);
#define G8_SA(b, h) (((b) * 2 + (h)) * HTB)
#define G8_SB(b, h) ((4 + (b) * 2 + (h)) * HTB)
#define G8_STAGE(bufoff, gptr, voff) do { _Pragma("unroll") for (int _i = 0; _i < 2; ++_i) \
        __builtin_amdgcn_global_load_lds((const unsigned*)((gptr) + (voff)[_i]), (LAS unsigned*)(lds + (bufoff) + ldsw + _i * 8192), 16, 0, 0); } while (0)
#define G8_LDA(dst, b, h) do { _Pragma("unroll") for (int m = 0; m < 4; ++m) _Pragma("unroll") for (int k = 0; k < 2; ++k) dst[m][k] = *(const LAS bf16x8*)(lds + G8_SA(b, h) + aoff + m * 2048 + k * 1024); } while (0)
#define G8_LDB(dst, b, h) do { _Pragma("unroll") for (int n = 0; n < 2; ++n) _Pragma("unroll") for (int k = 0; k < 2; ++k) dst[n][k] = *(const LAS bf16x8*)(lds + G8_SB(b, h) + boff + n * 2048 + k * 1024); } while (0)
#define G8_MMA(ai, bj, At, Bq) do { __builtin_amdgcn_s_setprio(1); _Pragma("unroll") for (int m = 0; m < 4; ++m) _Pragma("unroll") for (int n = 0; n < 2; ++n) _Pragma("unroll") for (int k = 0; k < 2; ++k) \
        acc[ai][bj][m][n] = __builtin_amdgcn_mfma_f32_16x16x32_bf16(Bq[n][k], At[m][k], acc[ai][bj][m][n], 0, 0, 0); __builtin_amdgcn_s_setprio(0); } while (0)
#define G8_WAIT_V(n) asm volatile("s_waitcnt vmcnt(" #n ")" ::: "memory")
#define G8_WAIT_L(n) asm volatile("s_waitcnt lgkmcnt(" #n ")" ::: "memory")
#define G8_BAR __builtin_amdgcn_s_barrier()
#define G8_SCHED __builtin_amdgcn_sched_barrier(0)
    int pm, pn, npm = 0, npn = 0, ui = 0;
    if (!unit_at(0, gridDim.x, blockIdx.x, nM, nN, pm, pn)) return;
    f32x4 acc[2][2][4][2];
#pragma unroll
    for (int a = 0; a < 2; ++a)
#pragma unroll
        for (int b = 0; b < 2; ++b)
#pragma unroll
            for (int m = 0; m < 4; ++m)
#pragma unroll
                for (int n = 0; n < 2; ++n) acc[a][b][m][n] = (f32x4){0.f, 0.f, 0.f, 0.f};
    bf16x8 At[4][2], B0[2][2], B1[2][2];
    const size_t hA = (size_t)HALF * lda, hB = (size_t)HALF * K;
    const u16* cA = A + (size_t)pm * BM * lda;
    const u16* cB = Bt + (size_t)pn * BM * K;
    G8_STAGE(G8_SB(0, 0), cB, offB); G8_STAGE(G8_SB(0, 1), cB + hB, offB); G8_STAGE(G8_SA(0, 0), cA, offA); G8_STAGE(G8_SA(0, 1), cA + hA, offA);
    if (wr == 1) G8_BAR;
    G8_WAIT_V(2); G8_BAR;
    G8_STAGE(G8_SB(1, 0), cB + BK, offB); G8_STAGE(G8_SA(1, 0), cA + BK, offA); G8_STAGE(G8_SB(1, 1), cB + hB + BK, offB);
    G8_WAIT_V(6); G8_BAR;
    for (;;) {
        const bool has_next = unit_at(ui + 1, gridDim.x, blockIdx.x, nM, nN, npm, npn);
        const u16* nA = has_next ? A + (size_t)npm * BM * lda : cA;
        const u16* nB = has_next ? Bt + (size_t)npn * BM * K : cB;
        for (int t = 0; t < nt; t += 2) {
            const bool last = (t == nt - 2);
            const u16* a1 = cA + (size_t)(t + 1) * BK;
            const u16* a2 = last ? nA : cA + (size_t)(t + 2) * BK;
            const u16* b2 = last ? nB : cB + (size_t)(t + 2) * BK;
            const u16* a3 = a2 + BK; const u16* b3 = b2 + BK;
            G8_LDB(B0, 0, 0); G8_LDB(B1, 0, 1); G8_SCHED; G8_LDA(At, 0, 0); G8_STAGE(G8_SA(1, 1), a1 + hA, offA);
            G8_WAIT_V(8); G8_WAIT_L(0); G8_BAR; G8_MMA(0, 0, At, B0); G8_MMA(0, 1, At, B1); G8_BAR; G8_SCHED;
            G8_LDA(At, 0, 1); G8_STAGE(G8_SB(0, 0), b2, offB); G8_STAGE(G8_SB(0, 1), b2 + hB, offB); G8_STAGE(G8_SA(0, 0), a2, offA);
            G8_WAIT_V(8); G8_WAIT_L(0); G8_BAR; G8_MMA(1, 0, At, B0); G8_MMA(1, 1, At, B1); G8_BAR; G8_SCHED;
            G8_LDB(B0, 1, 0); G8_LDB(B1, 1, 1); G8_SCHED; G8_LDA(At, 1, 0); G8_STAGE(G8_SA(0, 1), a2 + hA, offA);
            G8_WAIT_V(8); G8_WAIT_L(0); G8_BAR; G8_MMA(0, 0, At, B0); G8_MMA(0, 1, At, B1); G8_BAR; G8_SCHED;
            G8_LDA(At, 1, 1); G8_STAGE(G8_SB(1, 0), b3, offB); G8_STAGE(G8_SB(1, 1), b3 + hB, offB); G8_STAGE(G8_SA(1, 0), a3, offA);
            G8_WAIT_V(8); G8_WAIT_L(0); G8_BAR; G8_MMA(1, 0, At, B0); G8_MMA(1, 1, At, B1); G8_BAR; G8_SCHED;
        }
        if (wr == 0) G8_BAR;
        E(acc, pm * BM, pn * BM, wr, wc, fr, fq);
        if (!has_next) break;
#pragma unroll
        for (int a = 0; a < 2; ++a)
#pragma unroll
            for (int b = 0; b < 2; ++b)
#pragma unroll
                for (int m = 0; m < 4; ++m)
#pragma unroll
                    for (int n = 0; n < 2; ++n) acc[a][b][m][n] = (f32x4){0.f, 0.f, 0.f, 0.f};
        pm = npm; pn = npn; cA = nA; cB = nB; ++ui;
        if (wr == 1) G8_BAR;
    }
    G8_WAIT_V(0);
    G8_BAR;
}
}

struct Ctx {
    Params p; unsigned char* ws; LAS unsigned char* lds; int tid, lane, wave, gtid, gthreads, gwave, gwaves;
};

__device__ __forceinline__ void wconv_tile(const Ctx& c, const float* src, int ldsrc, int Nsrc, int k0s, int n0s, const float* kgain, u16* dst, int lddst, int n0d, int k0d) {
    LAS float* T = (LAS float*)c.lds;
    const int tid = c.tid;
    {
        const int k = tid >> 3, n8 = (tid & 7) * 8;
        f32x4 a = {0.f, 0.f, 0.f, 0.f}, b = {0.f, 0.f, 0.f, 0.f};
        if (src != nullptr && n0s + n8 < Nsrc) {
            const float* sp = src + (size_t)(k0s + k) * ldsrc + n0s + n8;
            a = *(const f32x4*)sp; b = *(const f32x4*)(sp + 4);
            if (kgain) { const float g = kgain[k0s + k]; a = a * g; b = b * g; }
        }
        LAS float* tp = T + k * 65 + n8;
        tp[0] = a[0]; tp[1] = a[1]; tp[2] = a[2]; tp[3] = a[3]; tp[4] = b[0]; tp[5] = b[1]; tp[6] = b[2]; tp[7] = b[3];
    }
    __syncthreads();
    {
        const int n = tid >> 3, k8 = (tid & 7) * 8;
        const LAS float* tp = T + k8 * 65 + n;
        u32x4 w;
        w.x = cvt_pk_bf16(tp[0], tp[65]); w.y = cvt_pk_bf16(tp[130], tp[195]); w.z = cvt_pk_bf16(tp[260], tp[325]); w.w = cvt_pk_bf16(tp[390], tp[455]);
        *(u32x4*)(dst + (size_t)(n0d + n) * lddst + k0d + k8) = w;
    }
    __syncthreads();
}

__device__ __forceinline__ void phase_wconv(const Ctx& c, int l) {
    u16* bt_in = (u16*)(c.ws + WS_BT_IN); u16* bt_mla = (u16*)(c.ws + WS_BT_MLA); u16* bt_out = (u16*)(c.ws + WS_BT_OUT);
    u16* bt_up = (u16*)(c.ws + WS_BT_UP); u16* bt_dn = (u16*)(c.ws + WS_BT_DN);
    const float* w_in = c.p.in[I_WIN] + (size_t)l * 1024 * INW;
    const float* wqb = c.p.in[I_WQB] + (size_t)l * 256 * 384;
    const float* wkvb = c.p.in[I_WKVB] + (size_t)l * 128 * 512;
    const float* w_out = c.p.in[I_WOUT] + (size_t)l * 1024 * 1024;
    const float* w_up = c.p.in[I_WUP] + (size_t)l * 1024 * 5632;
    const float* w_dn = c.p.in[I_WDOWN] + (size_t)l * DFF * 1024;
    constexpr int T_IN = 40 * 16, T_MLA = 16 * 8, T_OUT = 16 * 16, T_UP = 88 * 16, T_DN = 16 * 44;
    constexpr int T_ALL = T_IN + T_MLA + T_OUT + T_UP + T_DN;
    for (int it = blockIdx.x; it < T_ALL; it += gridDim.x) {
        int r = it;
        if (r < T_IN) { const int nt = r / 16, kt = r % 16; wconv_tile(c, w_in, INW, INW, kt * 64, nt * 64, nullptr, bt_in, 1024, nt * 64, kt * 64); continue; }
        r -= T_IN;
        if (r < T_MLA) {
            const int nt = r / 8, kt = r % 8;
            if (nt < 6 && kt < 4) wconv_tile(c, wqb, 384, 384, kt * 64, nt * 64, c.p.in[I_CQAG] + l * 256, bt_mla, 512, nt * 64, kt * 64);
            else if (nt >= 6 && nt < 14 && kt >= 4 && kt < 6) wconv_tile(c, wkvb, 512, 512, (kt - 4) * 64, (nt - 6) * 64, c.p.in[I_CKVAG] + l * 128, bt_mla, 512, nt * 64, kt * 64);
            else wconv_tile(c, nullptr, 0, 0, 0, 0, nullptr, bt_mla, 512, nt * 64, kt * 64);
            continue;
        }
        r -= T_MLA;
        if (r < T_OUT) { const int nt = r / 16, kt = r % 16; wconv_tile(c, w_out, 1024, 1024, kt * 64, nt * 64, nullptr, bt_out, 1024, nt * 64, kt * 64); continue; }
        r -= T_OUT;
        if (r < T_UP) { const int nt = r / 16, kt = r % 16, pn = nt >> 2, q = nt & 3;
            const int n0s = q < 2 ? 128 * pn + 64 * q : DFF + 128 * pn + 64 * (q - 2);
            wconv_tile(c, w_up, 5632, 5632, kt * 64, n0s, nullptr, bt_up, 1024, nt * 64, kt * 64); continue; }
        r -= T_UP;
        { const int nt = r / 44, kt = r % 44; wconv_tile(c, w_dn, 1024, 1024, kt * 64, nt * 64, nullptr, bt_dn, DFF, nt * 64, kt * 64); }
    }
}

__device__ __forceinline__ void phase_rope_table(const Ctx& c) {
    float2* tab = (float2*)(c.ws + WS_ROPE);
    for (int i = c.gtid; i < 4096 * 16; i += c.gthreads) {
        const int pos = i >> 4, fi = i & 15;
        const int f4 = fi & 3, f10 = fi >> 2;
        const float fb = f4 == 0 ? 1.0f : (f4 == 1 ? 0.5623413251903491f : (f4 == 2 ? 0.31622776601683794f : 0.1778279410038923f));
        const float fm = f10 == 0 ? 1.0f : (f10 == 1 ? 0.1f : (f10 == 2 ? 0.01f : 0.001f));
        const float f = fb * fm;
        const float ang = (float)pos * f;
        const double rev = (double)ang * 0.15915494309189535;
        const float fr = (float)(rev - rint(rev));
        tab[i] = make_float2(__builtin_amdgcn_cosf(fr), __builtin_amdgcn_sinf(fr));
    }
}

__device__ __forceinline__ void phase_rmsnorm(const Ctx& c, const float* x, const float* g, u16* xn) {
    f32x4 gv[4];
#pragma unroll
    for (int j = 0; j < 4; ++j) gv[j] = *(const f32x4*)(g + (j * 64 + c.lane) * 4);
    for (int row = c.gwave; row < NTOK; row += 2 * c.gwaves) {
        const int row2 = row + c.gwaves; const bool has2 = row2 < NTOK;
        const f32x4* xr = (const f32x4*)(x + (size_t)row * 1024) + c.lane;
        const f32x4* xr2 = (const f32x4*)(x + (size_t)(has2 ? row2 : row) * 1024) + c.lane;
        f32x4 v[4], v2[4]; float s = 0.f, s2 = 0.f;
#pragma unroll
        for (int j = 0; j < 4; ++j) { v[j] = xr[64 * j]; v2[j] = xr2[64 * j]; }
#pragma unroll
        for (int j = 0; j < 4; ++j) { s += (v[j][0] * v[j][0] + v[j][1] * v[j][1]) + (v[j][2] * v[j][2] + v[j][3] * v[j][3]); s2 += (v2[j][0] * v2[j][0] + v2[j][1] * v2[j][1]) + (v2[j][2] * v2[j][2] + v2[j][3] * v2[j][3]); }
        const float rs = rsqrtf(wave_sum(s) * (1.f / 1024.f) + EPS), rs2 = rsqrtf(wave_sum(s2) * (1.f / 1024.f) + EPS);
        u32x2* o = (u32x2*)(xn + (size_t)row * 1024) + c.lane;
#pragma unroll
        for (int j = 0; j < 4; ++j) { u32x2 w; w.x = cvt_pk_bf16(v[j][0] * rs * gv[j][0], v[j][1] * rs * gv[j][1]); w.y = cvt_pk_bf16(v[j][2] * rs * gv[j][2], v[j][3] * rs * gv[j][3]); o[64 * j] = w; }
        if (has2) { u32x2* o2 = (u32x2*)(xn + (size_t)row2 * 1024) + c.lane;
#pragma unroll
            for (int j = 0; j < 4; ++j) { u32x2 w; w.x = cvt_pk_bf16(v2[j][0] * rs2 * gv[j][0], v2[j][1] * rs2 * gv[j][1]); w.y = cvt_pk_bf16(v2[j][2] * rs2 * gv[j][2], v2[j][3] * rs2 * gv[j][3]); o2[64 * j] = w; } }
    }
}

template <int MODE, bool ROPE>
__device__ __forceinline__ void pp_vec64(const u16* src, u16* dst, const float* gain, int s, float prescale, const float2* tab) {
    float r1, r2;
    if (MODE == 0) { r1 = rsqrtf(sumsq_bf16<8>(src) * (1.f / 64.f) + EPS) * prescale; r2 = r1; }
    else { r1 = rsqrtf(sumsq_bf16<4>(src) * (1.f / 32.f) + EPS) * prescale; r2 = rsqrtf(sumsq_bf16<4>(src + 32) * (1.f / 32.f) + EPS) * prescale; }
#pragma unroll
    for (int hf = 0; hf < 2; ++hf) {
        float v[32]; load_bf16_vec<4>(src + 32 * hf, v);
        const float rr = hf == 0 ? r1 : r2;
        const float* gp = gain + (MODE == 0 ? 32 * hf : 0);
#pragma unroll
        for (int i = 0; i < 32; ++i) v[i] = v[i] * rr * gp[i];
        if (ROPE) {
            const float2* t = tab + (hf == 0 ? (s >> 6) : (s & 63)) * 16;
#pragma unroll
            for (int i = 0; i < 16; ++i) { const float2 a = t[i]; const float x1 = v[i], x2 = v[16 + i]; v[i] = x1 * a.x - x2 * a.y; v[16 + i] = x1 * a.y + x2 * a.x; }
        }
        store_bf16_vec<4>(dst + 32 * hf, v);
    }
}
template <int NA>
__device__ __forceinline__ void pp_vec96(const u16* srcA, float rsA, const u16* srcB, u16* dst, const float* gain, int s, float prescale, const float2* tab) {
    float ss = sumsq_bf16<NA / 8>(srcA) * rsA * rsA;
    if (NA < 96) ss += sumsq_bf16<(96 - NA) / 8>(srcB);
    const float rn = rsqrtf(ss * (1.f / 96.f) + EPS) * prescale;
    const float ra = rn * rsA;
#pragma unroll 2
    for (int cch = 0; cch < 8; ++cch) {
        float v[8]; load_bf16_vec<1>(srcA + 8 * cch, v);
#pragma unroll
        for (int i = 0; i < 8; ++i) v[i] = v[i] * ra * gain[8 * cch + i];
        store_bf16_vec<1>(dst + 8 * cch, v);
    }
    float v[32];
    if (NA == 96) { load_bf16_vec<4>(srcA + 64, v);
#pragma unroll
        for (int i = 0; i < 32; ++i) v[i] = v[i] * ra * gain[64 + i]; }
    else { load_bf16_vec<4>(srcB, v);
#pragma unroll
        for (int i = 0; i < 32; ++i) v[i] = v[i] * rn * gain[64 + i]; }
    const float2* t = tab + s * 16;
#pragma unroll
    for (int i = 0; i < 16; ++i) { const float2 a = t[i]; const float x1 = v[i], x2 = v[16 + i]; v[i] = x1 * a.x - x2 * a.y; v[16 + i] = x1 * a.y + x2 * a.x; }
    store_bf16_vec<4>(dst + 64, v);
}

__device__ __forceinline__ void vtrans_tile4(const Ctx& c, const u16* src, int ldsrc, size_t tok0, int tstride, const u16* rs_src  , u16* dst  ) {
    LAS unsigned char* T = c.lds;
    LAS float* RS = (LAS float*)(c.lds + 32768);
    const int tid = c.tid;
    u32x4 w[4];
#pragma unroll
    for (int i = 0; i < 4; ++i) { const int p = i * 64 + (tid >> 3), cc = tid & 7; w[i] = *(const u32x4*)(src + (tok0 + (size_t)p * tstride) * ldsrc + cc * 8); }
    if (rs_src) {
        const int p = tid >> 1, part = tid & 1;
        float s = sumsq_bf16<8>(rs_src + (tok0 + (size_t)p * tstride) * INWP + 1536 + part * 64);
        s += __shfl_xor(s, 1);
        if (part == 0) RS[p] = rsqrtf(s * (1.f / 128.f) + EPS);
        __syncthreads();
#pragma unroll
        for (int i = 0; i < 4; ++i) { const float r = RS[i * 64 + (tid >> 3)];
            w[i].x = cvt_pk_bf16(bf_lo(w[i].x) * r, bf_hi(w[i].x) * r); w[i].y = cvt_pk_bf16(bf_lo(w[i].y) * r, bf_hi(w[i].y) * r);
            w[i].z = cvt_pk_bf16(bf_lo(w[i].z) * r, bf_hi(w[i].z) * r); w[i].w = cvt_pk_bf16(bf_lo(w[i].w) * r, bf_hi(w[i].w) * r); }
    }
#pragma unroll
    for (int i = 0; i < 4; ++i) { const int p = i * 64 + (tid >> 3), cc = tid & 7; *(LAS u32x4*)(T + p * 128 + ((cc ^ ((p >> 3) & 7)) * 16)) = w[i]; }
    __syncthreads();
#pragma unroll
    for (int i = 0; i < 4; ++i) {
        const int d = tid >> 3, pc = (tid & 7) + 8 * i;
        const LAS unsigned char* tp = T + (8 * pc) * 128 + (((d >> 3) ^ (pc & 7)) * 16) + (d & 7) * 2;
        unsigned e[8];
#pragma unroll
        for (int j = 0; j < 8; ++j) e[j] = *(const LAS u16*)(tp + j * 128);
        u32x4 o; o.x = e[0] | (e[1] << 16); o.y = e[2] | (e[3] << 16); o.z = e[4] | (e[5] << 16); o.w = e[6] | (e[7] << 16);
        *(u32x4*)(dst + (size_t)d * 4096 + pc * 8) = o;
    }
    __syncthreads();
}

__device__ __forceinline__ void phase_pp(const Ctx& c, int l) {
    const u16* proj = (const u16*)(c.ws + WS_R1);
    const u16* cbuf = (const u16*)(c.ws + WS_XN);
    const float2* tab = (const float2*)(c.ws + WS_ROPE);
    const float sA = 0.125f * LOG2E, sB = 0.17677669529663687f * LOG2E, sC = 0.10206207261596575f * LOG2E;
    { u16* Kp = (u16*)(c.ws + WS_KA); const float* g = c.p.in[I_AKN] + l * 64;
      for (int j = c.gtid; j < NTOK * 2; j += c.gthreads) { const int T = j >> 1, hh = j & 1, b = T >> 12, s = T & 4095;
        pp_vec64<0, true>(proj + (size_t)T * INWP + 256 + hh * 64, Kp + ((size_t)(b * 2 + hh) * 4096 + s) * 64, g, s, 1.f, tab); } }
    { u16* Kp = (u16*)(c.ws + WS_KB); const float* g = c.p.in[I_BKN] + l * 32;
      for (int j = c.gtid; j < NTOK * 4; j += c.gthreads) { const int T = j >> 2, hh = j & 3, b = T >> 12, s = T & 4095;
        pp_vec64<1, false>(proj + (size_t)T * INWP + 768 + hh * 64, Kp + ((size_t)(b * 4 + hh) * 4096 + s) * 64, g, s, 1.f, tab); } }
    { u16* Kp = (u16*)(c.ws + WS_KD); const float* g = c.p.in[I_DKN] + l * 64;
      for (int j = c.gtid; j < NTOK * 4; j += c.gthreads) { const int T = j >> 2, hh = j & 3, b = T >> 12, s = T & 4095;
        pp_vec64<0, false>(proj + (size_t)T * INWP + 1952 + hh * 64, Kp + ((size_t)(b * 4 + hh) * 4096 + s) * 64, g, s, 1.f, tab); } }
    { u16* Q = (u16*)(c.ws + WS_QC); const float* g = c.p.in[I_CQN] + l * 96;
      for (int j = c.gtid; j < NTOK * 4; j += c.gthreads) { const int T = j >> 2, hh = j & 3, b = T >> 12, s = T & 4095;
        float ssl = sumsq_bf16<8>(proj + (size_t)T * INWP + 1280 + hh * 64);
        ssl += __shfl_xor(ssl, 1); ssl += __shfl_xor(ssl, 2);
        const float rs = rsqrtf(ssl * (1.f / 256.f) + EPS);
        pp_vec96<96>(cbuf + (size_t)T * 1024 + hh * 96, rs, nullptr, Q + ((size_t)(b * 4 + hh) * 4096 + s) * 96, g, s, sC, tab); } }
    { u16* Kp = (u16*)(c.ws + WS_KC); const float* g = c.p.in[I_CKN] + l * 96;
      for (int j = c.gtid; j < NTOK * 4; j += c.gthreads) { const int T = j >> 2, hh = j & 3, b = T >> 12, s = T & 4095;
        float ssl = sumsq_bf16<4>(proj + (size_t)T * INWP + 1536 + hh * 32);
        ssl += __shfl_xor(ssl, 1); ssl += __shfl_xor(ssl, 2);
        const float rs = rsqrtf(ssl * (1.f / 128.f) + EPS);
        pp_vec96<64>(cbuf + (size_t)T * 1024 + 384 + hh * 128, rs, proj + (size_t)T * INWP + 1664, Kp + ((size_t)(b * 4 + hh) * 4096 + s) * 96, g, s, 1.f, tab); } }
    for (int j = blockIdx.x; j < 22 * 8 * 16; j += gridDim.x) {
        const int tile = j & 15, b = (j >> 4) & 7, kind = j >> 7;
        const size_t tb = (size_t)b * 4096;
        const int p0 = tile * 256;
        if (kind < 2) { const int hh = kind; vtrans_tile4(c, proj + 384 + hh * 64, INWP, tb + p0, 1, nullptr, (u16*)(c.ws + WS_VTA) + (size_t)(b * 2 + hh) * 64 * 4096 + p0); }
        else if (kind < 6) { const int hh = kind - 2; vtrans_tile4(c, proj + 1024 + hh * 64, INWP, tb + p0, 1, nullptr, (u16*)(c.ws + WS_VTB) + (size_t)(b * 4 + hh) * 64 * 4096 + p0); }
        else if (kind < 10) { const int hh = kind - 6; vtrans_tile4(c, cbuf + 384 + hh * 128 + 64, 1024, tb + p0, 1, proj, (u16*)(c.ws + WS_VTC) + (size_t)(b * 4 + hh) * 64 * 4096 + p0); }
        else { const int k2 = kind - 10, br = k2 >> 2, hh = k2 & 3; const int dil = br == 0 ? 1 : (br == 1 ? 4 : 16), L = 4096 / dil;
               const int r = p0 / L, j0 = p0 % L;
               vtrans_tile4(c, proj + 2208 + hh * 64, INWP, tb + (size_t)j0 * dil + r, dil, nullptr, (u16*)(c.ws + WS_VTD) + (size_t)((br * 8 + b) * 4 + hh) * 64 * 4096 + p0); }
    }
}

#define AT_BAR() do { asm volatile("s_waitcnt lgkmcnt(0)" ::: "memory"); __builtin_amdgcn_s_barrier(); asm volatile("" ::: "memory"); } while (0)
template <int TYPE>
__device__ __forceinline__ void attn_unit(const Ctx& c, int l, int b, int hh, int qb, int br) {
    constexpr int DQK = TYPE == 2 ? 96 : 64;
    constexpr int CPR = DQK / 8;
    constexpr int KROWB = DQK * 2 + 16;
    constexpr int KTB = 64 * KROWB;
    constexpr int VROWB = 144;
    constexpr int BUFB = KTB + 64 * VROWB;
    constexpr int NPASS = TYPE == 1 ? 2 : 1;
    constexpr int NKK = TYPE == 1 ? 2 : DQK / 16;
    constexpr bool PIPE = TYPE != 1;
    LAS unsigned char* lds = c.lds;
    int tid_ = c.tid; asm volatile("" : "+v"(tid_));
    asm volatile("" : "+s"(l), "+s"(b), "+s"(hh), "+s"(qb), "+s"(br));
    const int tid = tid_, lane = tid & 63, w = __builtin_amdgcn_readfirstlane(tid >> 6), q31 = lane & 31, h = lane >> 5;
    int dil = 1, r = 0, L = 4096, j0 = qb * 256;
    if (TYPE == 3) { dil = br == 0 ? 1 : (br == 1 ? 4 : 16); L = 4096 / dil; const int P0 = qb * 256; r = P0 / L; j0 = P0 % L; }
    const u16 *Qg, *Kg, *Vg;
    const float *gq, *gk; int ng;
    if (TYPE == 0) { Qg = (const u16*)(c.ws + WS_QA) + (size_t)(b * 4 + hh) * 4096 * 64; Kg = (const u16*)(c.ws + WS_KA) + (size_t)(b * 2 + (hh >> 1)) * 4096 * 64;
                     Vg = (const u16*)(c.ws + WS_VTA) + (size_t)(b * 2 + (hh >> 1)) * 64 * 4096; gq = c.p.in[I_AQN] + l * 64; gk = c.p.in[I_AKN] + l * 64; ng = 64; }
    else if (TYPE == 1) { Qg = (const u16*)(c.ws + WS_QB) + (size_t)(b * 4 + hh) * 4096 * 64; Kg = (const u16*)(c.ws + WS_KB) + (size_t)(b * 4 + hh) * 4096 * 64;
                     Vg = (const u16*)(c.ws + WS_VTB) + (size_t)(b * 4 + hh) * 64 * 4096; gq = c.p.in[I_BQN] + l * 32; gk = c.p.in[I_BKN] + l * 32; ng = 32; }
    else if (TYPE == 2) { Qg = (const u16*)(c.ws + WS_QC) + (size_t)(b * 4 + hh) * 4096 * 96; Kg = (const u16*)(c.ws + WS_KC) + (size_t)(b * 4 + hh) * 4096 * 96;
                     Vg = (const u16*)(c.ws + WS_VTC) + (size_t)(b * 4 + hh) * 64 * 4096; gq = c.p.in[I_CQN] + l * 96; gk = c.p.in[I_CKN] + l * 96; ng = 96; }
    else { Qg = (const u16*)(c.ws + WS_QD) + (size_t)(b * 4 + hh) * 4096 * 64; Kg = (const u16*)(c.ws + WS_KD) + (size_t)(b * 4 + hh) * 4096 * 64;
                     Vg = (const u16*)(c.ws + WS_VTD) + (size_t)((br * 8 + b) * 4 + hh) * 64 * 4096 + (size_t)r * L; gq = c.p.in[I_DQN] + l * 64; gk = c.p.in[I_DKN] + l * 64; ng = 64; }
    const float scale = TYPE == 1 ? 0.17677669529663687f : (TYPE == 2 ? 0.10206207261596575f : 0.125f);
    const float Mp = (float)ng * wave_absmax(gq, ng, lane) * wave_absmax(gk, ng, lane) * scale * LOG2E * 1.02f;
    float sl = 0.f;
    if (TYPE == 1) sl = exp2f(-(float)(hh + 1)) * LOG2E;
    if (TYPE == 3) sl = exp2f(-(float)(hh + 5)) * LOG2E * (float)dil;
    int klo = 0, khi = L;
    if (TYPE == 1) { const int W = (int)((2.f * Mp + 50.f) / sl) + 1; klo = j0 - W; khi = j0 + 256 + W; klo = klo < 0 ? 0 : (klo & ~63); khi = khi > L ? L : ((khi + 63) & ~63); }
    if (TYPE == 3) { klo = j0 - 64; khi = j0 + 320; klo = klo < 0 ? 0 : klo; khi = khi > L ? L : khi; }
    const int ntile = (khi - klo) >> 6;
    const int jq = j0 + 32 * w + q31;
    const int pi = (q31 & ~12) | ((q31 & 4) << 1) | ((q31 & 8) >> 1);
    const int vfo = q31 * VROWB + h * 16;
    const int krow0 = tid / CPR, kcc0 = tid % CPR, krow1 = (tid + 512) / CPR, kcc1 = (tid + 512) % CPR;
    const int vd = tid >> 3, vcc = tid & 7;
    f32x16 O[2], Osv[2];
    float lsum = 0.f;
#pragma unroll
    for (int d = 0; d < 2; ++d)
#pragma unroll
        for (int i = 0; i < 16; ++i) Osv[d][i] = 0.f;
#pragma unroll 1
    for (int pass = 0; pass < NPASS; ++pass) {
        const int kfo = pi * KROWB + h * 16 + pass * 64;
        bf16x8 qf[NKK];
        if (TYPE == 2) {
            const u16* qrow = Qg + ((size_t)jq * dil + r) * DQK + h * 8 + pass * 32;
#pragma unroll
            for (int kk = 0; kk < NKK; ++kk) qf[kk] = *(const bf16x8*)(qrow + kk * 16);
        } else {
            const int sq_ = jq * dil + r;
            const u16* qraw = (const u16*)(c.ws + WS_R1) + ((size_t)b * 4096 + sq_) * INWP + (TYPE == 0 ? 0 : (TYPE == 1 ? 512 : 1696)) + hh * 64 + h * 8 + pass * 32;
            float qv[NKK][8];
            float ssq = 0.f;
#pragma unroll
            for (int kk = 0; kk < NKK; ++kk) { load_bf16_vec<1>(qraw + kk * 16, qv[kk]);
#pragma unroll
                for (int j = 0; j < 8; ++j) ssq += qv[kk][j] * qv[kk][j]; }
            ssq += __shfl_xor(ssq, 32);
            const float rnq = rsqrtf(ssq * (1.f / (float)(16 * NKK)) + EPS) * (scale * LOG2E);
#pragma unroll
            for (int kk = 0; kk < NKK; ++kk) { const f32x4 g0 = *(const f32x4*)(gq + kk * 16 + h * 8), g1 = *(const f32x4*)(gq + kk * 16 + h * 8 + 4);
#pragma unroll
                for (int j = 0; j < 4; ++j) { qv[kk][j] *= rnq * g0[j]; qv[kk][4 + j] *= rnq * g1[j]; } }
            if (TYPE == 0) {
                const float2* tab = (const float2*)(c.ws + WS_ROPE);
#pragma unroll
                for (int hf = 0; hf < 2; ++hf) {
                    const float2* t = tab + (hf == 0 ? (sq_ >> 6) : (sq_ & 63)) * 16 + h * 8;
#pragma unroll
                    for (int j = 0; j < 8; ++j) { const float2 a = t[j]; const float x1 = qv[NKK >= 4 ? 2 * hf : 0][j], x2 = qv[NKK >= 4 ? 2 * hf + 1 : 1][j];
                        qv[NKK >= 4 ? 2 * hf : 0][j] = x1 * a.x - x2 * a.y; qv[NKK >= 4 ? 2 * hf + 1 : 1][j] = x1 * a.y + x2 * a.x; }
                }
            }
#pragma unroll
            for (int kk = 0; kk < NKK; ++kk) { u32x4 pw;
                pw.x = cvt_pk_bf16(qv[kk][0], qv[kk][1]); pw.y = cvt_pk_bf16(qv[kk][2], qv[kk][3]); pw.z = cvt_pk_bf16(qv[kk][4], qv[kk][5]); pw.w = cvt_pk_bf16(qv[kk][6], qv[kk][7]);
                qf[kk] = __builtin_bit_cast(bf16x8, pw); }
        }
        lsum = 0.f;
#pragma unroll
        for (int d = 0; d < 2; ++d)
#pragma unroll
            for (int i = 0; i < 16; ++i) O[d][i] = 0.f;
        constexpr int VB0 = 2 * KTB;
        u32x4 kr0, kr1 = {0u, 0u, 0u, 0u}, vr;
#define AT_GLOADK(kp0) do { kr0 = *(const u32x4*)(Kg + ((size_t)((kp0) + krow0) * dil + r) * DQK + kcc0 * 8); \
        if (DQK == 96 && tid < 256) kr1 = *(const u32x4*)(Kg + ((size_t)((kp0) + krow1) * dil + r) * DQK + kcc1 * 8); } while (0)
#define AT_GLOADV(kp0) do { vr = *(const u32x4*)(Vg + (size_t)vd * 4096 + (kp0) + vcc * 8); } while (0)
#define AT_LWRITEK(buf) do { *(LAS u32x4*)(lds + (buf) * KTB + krow0 * KROWB + kcc0 * 16) = kr0; \
        if (DQK == 96 && tid < 256) *(LAS u32x4*)(lds + (buf) * KTB + krow1 * KROWB + kcc1 * 16) = kr1; } while (0)
#define AT_LWRITEV(buf) do { *(LAS u32x4*)(lds + VB0 + (buf) * 64 * VROWB + vd * VROWB + vcc * 16) = vr; } while (0)
#define AT_QK(Sx, kbuf_, kp0_) do { \
        _Pragma("unroll") for (int kb = 0; kb < 2; ++kb) { \
            if (TYPE == 1 || TYPE == 3) { \
                const float tq = (float)(jq - (kp0_) - 8 * h - kb * 32); \
                _Pragma("unroll") for (int i = 0; i < 16; ++i) { \
                    const float dd = fabsf(tq - (float)(16 * (i >> 3) + (i & 7))); \
                    float v_ = -Mp - sl * dd; \
                    if (TYPE == 3) v_ = dd <= 64.f ? v_ : -INFINITY; \
                    Sx[kb][i] = v_; } \
            } else { _Pragma("unroll") for (int i = 0; i < 16; ++i) Sx[kb][i] = -Mp; } } \
        _Pragma("unroll") for (int kk = 0; kk < NKK; ++kk) \
            _Pragma("unroll") for (int kb = 0; kb < 2; ++kb) {     \
                const bf16x8 kf = *(const LAS bf16x8*)(lds + (kbuf_) * KTB + kfo + kb * 32 * KROWB + kk * 32); \
                Sx[kb] = __builtin_amdgcn_mfma_f32_32x32x16_bf16(kf, qf[kk], Sx[kb], 0, 0, 0); } } while (0)
        f32x16 S[2][2];
        const int jw = j0 + 32 * w;
#define AT_ACTIVE(kp0_) (TYPE != 3 || (((kp0_) + 63 >= jw - 64) && ((kp0_) <= jw + 31 + 64)))
        AT_GLOADK(klo); AT_GLOADV(klo); AT_LWRITEK(0); AT_LWRITEV(0);
        if (PIPE && ntile > 1) { AT_GLOADK(klo + 64); AT_LWRITEK(1); }
        AT_BAR();
        if (PIPE) { if (AT_ACTIVE(klo)) AT_QK(S[0], 0, klo);
                    AT_BAR(); }
        for (int t0 = 0; t0 < ntile; t0 += 2) {
#pragma unroll
          for (int half = 0; half < 2; ++half) {
            const int t = t0 + half;
            if (t < ntile) {
            const int kp0 = klo + t * 64;
            if (PIPE ? t + 2 < ntile : t + 1 < ntile) AT_GLOADK(kp0 + (PIPE ? 128 : 64));
            if (t + 1 < ntile) AT_GLOADV(kp0 + 64);
            if (PIPE) { if (t + 1 < ntile && AT_ACTIVE(kp0 + 64)) AT_QK(S[half ^ 1], half ^ 1, kp0 + 64); }
            if (AT_ACTIVE(kp0)) {
                if (!PIPE) AT_QK(S[half], half, kp0);
                bf16x8 pf[4];
#pragma unroll
                for (int kb = 0; kb < 2; ++kb) {
                    float ps = 0.f;
                    float pe[16];
#pragma unroll
                    for (int i = 0; i < 16; ++i) { pe[i] = __builtin_amdgcn_exp2f(S[half][kb][i]); ps += pe[i]; }
                    lsum += ps;
#pragma unroll
                    for (int s2 = 0; s2 < 2; ++s2) {
                        u32x4 pw;
                        pw.x = cvt_pk_bf16(pe[8 * s2 + 0], pe[8 * s2 + 1]); pw.y = cvt_pk_bf16(pe[8 * s2 + 2], pe[8 * s2 + 3]);
                        pw.z = cvt_pk_bf16(pe[8 * s2 + 4], pe[8 * s2 + 5]); pw.w = cvt_pk_bf16(pe[8 * s2 + 6], pe[8 * s2 + 7]);
                        pf[kb * 2 + s2] = __builtin_bit_cast(bf16x8, pw);
                    }
                }
#pragma unroll
                for (int ks = 0; ks < 4; ++ks)
#pragma unroll
                    for (int db = 0; db < 2; ++db) {
                        const bf16x8 vf = *(const LAS bf16x8*)(lds + VB0 + half * 64 * VROWB + vfo + db * 32 * VROWB + ks * 32);
                        O[db] = __builtin_amdgcn_mfma_f32_32x32x16_bf16(vf, pf[ks], O[db], 0, 0, 0);
                    }
            }
            if (PIPE ? t + 2 < ntile : t + 1 < ntile) AT_LWRITEK(PIPE ? half : half ^ 1);
            if (t + 1 < ntile) AT_LWRITEV(half ^ 1);
            AT_BAR();
            }
          }
        }
#undef AT_GLOADK
#undef AT_GLOADV
#undef AT_LWRITEK
#undef AT_LWRITEV
#undef AT_QK
#undef AT_ACTIVE
        if (TYPE == 1 && pass == 0) {
            const float i1 = __builtin_amdgcn_rcpf(lsum + __shfl_xor(lsum, 32));
#pragma unroll
            for (int d = 0; d < 2; ++d)
#pragma unroll
                for (int i = 0; i < 16; ++i) Osv[d][i] = O[d][i] * i1;
        }
    }
    const int sq = jq * dil + r;
    const size_t tok = (size_t)b * 4096 + sq;
    const float lt = lsum + __shfl_xor(lsum, 32);
    if (TYPE == 0 || TYPE == 2) {
        const float inv = __builtin_amdgcn_rcpf(lt);
        u16* op = (u16*)(c.ws + WS_MIX) + tok * 1024 + (TYPE == 0 ? 0 : 512) + hh * 64;
#pragma unroll
        for (int db = 0; db < 2; ++db)
#pragma unroll
            for (int gp = 0; gp < 2; ++gp) {
                u32x2 ev, od;
                ev.x = cvt_pk_bf16(O[db][8 * gp + 0] * inv, O[db][8 * gp + 1] * inv); ev.y = cvt_pk_bf16(O[db][8 * gp + 2] * inv, O[db][8 * gp + 3] * inv);
                od.x = cvt_pk_bf16(O[db][8 * gp + 4] * inv, O[db][8 * gp + 5] * inv); od.y = cvt_pk_bf16(O[db][8 * gp + 6] * inv, O[db][8 * gp + 7] * inv);
                const unsigned sx = h ? ev.x : od.x, sy = h ? ev.y : od.y;
                const unsigned rx = (unsigned)__shfl_xor((int)sx, 32), ry = (unsigned)__shfl_xor((int)sy, 32);
                u32x4 w4;
                if (h) { w4.x = rx; w4.y = ry; w4.z = od.x; w4.w = od.y; } else { w4.x = ev.x; w4.y = ev.y; w4.z = rx; w4.w = ry; }
                *(u32x4*)(op + db * 32 + 16 * gp + 8 * h) = w4;
            }
    } else if (TYPE == 1) {
        float pr = lane < 32 ? c.p.in[I_LQ1][l * 32 + lane] * c.p.in[I_LK1][l * 32 + lane] : c.p.in[I_LQ2][l * 32 + lane - 32] * c.p.in[I_LK2][l * 32 + lane - 32];
#pragma unroll
        for (int o = 1; o < 32; o <<= 1) pr += __shfl_xor(pr, o);
        const float s1 = __shfl(pr, 0), s2 = __shfl(pr, 32);
        const float lam_init = 0.8f - 0.6f * expf(-0.3f * (float)l);
        const float lam = expf(s1) - expf(s2) + lam_init;
        const float i2 = lam * __builtin_amdgcn_rcpf(lt);
        float ss = 0.f;
#pragma unroll
        for (int db = 0; db < 2; ++db)
#pragma unroll
            for (int i = 0; i < 16; ++i) { const float o = Osv[db][i] - O[db][i] * i2; O[db][i] = o; ss += o * o; }
        ss += __shfl_xor(ss, 32);
        const float rn = rsqrtf(ss * (1.f / 64.f) + EPS) * (1.f - lam_init);
        const float* gs = c.p.in[I_BSUB] + l * 64 + 4 * h;
        u16* op = (u16*)(c.ws + WS_MIX) + tok * 1024 + 256 + hh * 64 + 4 * h;
#pragma unroll
        for (int db = 0; db < 2; ++db)
#pragma unroll
            for (int g = 0; g < 4; ++g) {
                const f32x4 gv = *(const f32x4*)(gs + db * 32 + 8 * g);
                u32x2 wv; wv.x = cvt_pk_bf16(O[db][4 * g] * rn * gv[0], O[db][4 * g + 1] * rn * gv[1]); wv.y = cvt_pk_bf16(O[db][4 * g + 2] * rn * gv[2], O[db][4 * g + 3] * rn * gv[3]);
                *(u32x2*)(op + db * 32 + 8 * g) = wv;
            }
    } else {
        const float inv = __builtin_amdgcn_rcpf(lt);
        u16* op = (u16*)(c.ws + dpart_off(br)) + tok * 256 + hh * 64;
#pragma unroll
        for (int db = 0; db < 2; ++db)
#pragma unroll
            for (int gp = 0; gp < 2; ++gp) {
                u32x2 ev, od;
                ev.x = cvt_pk_bf16(O[db][8 * gp + 0] * inv, O[db][8 * gp + 1] * inv); ev.y = cvt_pk_bf16(O[db][8 * gp + 2] * inv, O[db][8 * gp + 3] * inv);
                od.x = cvt_pk_bf16(O[db][8 * gp + 4] * inv, O[db][8 * gp + 5] * inv); od.y = cvt_pk_bf16(O[db][8 * gp + 6] * inv, O[db][8 * gp + 7] * inv);
                const unsigned sx = h ? ev.x : od.x, sy = h ? ev.y : od.y;
                const unsigned rx = (unsigned)__shfl_xor((int)sx, 32), ry = (unsigned)__shfl_xor((int)sy, 32);
                u32x4 w4;
                if (h) { w4.x = rx; w4.y = ry; w4.z = od.x; w4.w = od.y; } else { w4.x = ev.x; w4.y = ev.y; w4.z = rx; w4.w = ry; }
                *(u32x4*)(op + db * 32 + 16 * gp + 8 * h) = w4;
            }
        if (h == 0) ((float*)(c.ws + WS_LD))[((size_t)br * NTOK + tok) * 4 + hh] = lt;
    }
}

__device__ __forceinline__ void phase_attn(const Ctx& c, int l) {
    for (int u = blockIdx.x; u < 1536; u += gridDim.x) {
        const int type = u >> 9;
        const int v = u & 511;
        const int k = v >> 8, i = v & 255, xcd = i & 7, slot = i >> 3;
        const int pair = k * 16 + xcd * 2 + (slot >> 4), b = pair >> 2, qb = slot & 15;
        int hh = pair & 3;
        if (type == 1 && k == 1) hh = 3 - hh;
        if (type == 0) attn_unit<0>(c, l, b, hh, qb, 0);
        else if (type == 1) attn_unit<1>(c, l, b, hh, qb, 0);
        else attn_unit<2>(c, l, b, hh, qb, 0);
    }
    unsigned* ticket = (unsigned*)(c.ws + WS_BAR) + TICKET_WORD0 + 64 * l;
    volatile LAS unsigned* tk = (volatile LAS unsigned*)(c.lds + 131072 + 16);
    for (;;) {
        __syncthreads();
        if (threadIdx.x == 0) tk[0] = __hip_atomic_fetch_add(ticket, 1u, __ATOMIC_RELAXED, __HIP_MEMORY_SCOPE_AGENT);
        __syncthreads();
        const int v = (int)tk[0];
        if (v >= 1536) break;
        const int br = v >> 9, w_ = v & 511;
        const int b = w_ >> 6, hh = (w_ >> 4) & 3, qb = w_ & 15;
        attn_unit<3>(c, l, b, hh, qb, br);
    }
}

__device__ __forceinline__ void phase_dmerge(const Ctx& c) {
    const float* ld = (const float*)(c.ws + WS_LD); u16* mix = (u16*)(c.ws + WS_MIX);
    for (int j = c.gtid; j < NTOK * 32; j += c.gthreads) {
        const int tok = j >> 5, ch = j & 31, hh = ch >> 3;
        float acc[8]; float lt = 0.f;
#pragma unroll
        for (int i = 0; i < 8; ++i) acc[i] = 0.f;
#pragma unroll
        for (int br = 0; br < 3; ++br) {
            const float lb = ld[((size_t)br * NTOK + tok) * 4 + hh]; lt += lb;
            float v[8]; load_bf16_vec<1>((const u16*)(c.ws + dpart_off(br)) + (size_t)tok * 256 + ch * 8, v);
#pragma unroll
            for (int i = 0; i < 8; ++i) acc[i] += lb * v[i];
        }
        const float inv = __builtin_amdgcn_rcpf(lt);
#pragma unroll
        for (int i = 0; i < 8; ++i) acc[i] *= inv;
        store_bf16_vec<1>(mix + (size_t)tok * 1024 + 768 + ch * 8, acc);
    }
}

__device__ __forceinline__ void phase_ffn_fixup(const Ctx& c, int l) {
    const u16* hb = (const u16*)(c.ws + WS_HB); u16* act = (u16*)(c.ws + WS_ACT);
    const float* cw = c.p.in[I_CONVW] + (size_t)l * 3 * 5632; const float* cb = c.p.in[I_CONVB] + (size_t)l * 5632;
    for (int j = c.gtid; j < 512 * 2 * 352; j += c.gthreads) {
        const int ch = j % 352, e = (j / 352) & 1, blk = j / 704;
        const int row = blk * 64 + (e ? 63 : 0), s = row & 4095, c0 = ch * 8;
        const int hc = 256 * (c0 >> 7) + (c0 & 127);
        const u16* yu = e ? hb + ((size_t)blk * 4 + 2) * 5632 : hb + ((size_t)(blk - 1) * 4 + 3) * 5632;
        const u16* yc = hb + ((size_t)blk * 4 + (e ? 3 : 0)) * 5632;
        const u16* yd = e ? hb + ((size_t)(blk + 1) * 4 + 0) * 5632 : hb + ((size_t)blk * 4 + 1) * 5632;
        const bool hasu = e || s != 0, hasd = !e || s != 4095;
        float gu[8], gc[8], gd[8], vu[8], vc[8], vd[8];
        load_bf16_vec<1>(yc + hc, gc); load_bf16_vec<1>(yc + hc + 128, vc);
        if (hasu) { load_bf16_vec<1>(yu + hc, gu); load_bf16_vec<1>(yu + hc + 128, vu); }
        else {
#pragma unroll
            for (int i = 0; i < 8; ++i) { gu[i] = 0.f; vu[i] = 0.f; } }
        if (hasd) { load_bf16_vec<1>(yd + hc, gd); load_bf16_vec<1>(yd + hc + 128, vd); }
        else {
#pragma unroll
            for (int i = 0; i < 8; ++i) { gd[i] = 0.f; vd[i] = 0.f; } }
        float o[8];
#pragma unroll
        for (int i = 0; i < 8; ++i) {
            const float ug = gu[i] * cw[c0 + i] + gc[i] * cw[5632 + c0 + i] + gd[i] * cw[2 * 5632 + c0 + i] + cb[c0 + i];
            const float uv = vu[i] * cw[DFF + c0 + i] + vc[i] * cw[5632 + DFF + c0 + i] + vd[i] * cw[2 * 5632 + DFF + c0 + i] + cb[DFF + c0 + i];
            o[i] = ug * __builtin_amdgcn_rcpf(1.f + __expf(-ug)) * uv;
        }
        store_bf16_vec<1>(act + (size_t)row * DFF + c0, o);
    }
}

#define XB_TMO      128
#define XB_XCNT(j)  (256  + 64 * (j))
#define XB_XSUB(j)  (1280 + 64 * (j))
#define XB_XGEN(j)  (2304 + 64 * (j))
#define XB_TOP      3328
#define XB_TOPGEN   3392
#define XCD_BAR_WORDS 3456
#define XB_SPIN_CAP (1u << 18)

__device__ __forceinline__ unsigned xb_ld(unsigned* p)              { return __hip_atomic_load(p, __ATOMIC_RELAXED, __HIP_MEMORY_SCOPE_AGENT); }
__device__ __forceinline__ unsigned xb_add(unsigned* p, unsigned v) { return __hip_atomic_fetch_add(p, v, __ATOMIC_RELAXED, __HIP_MEMORY_SCOPE_AGENT); }
__device__ __forceinline__ unsigned xb_xcc_id() { return (unsigned)__builtin_amdgcn_s_getreg((3 << 11) | 20) & 0xFu; }
#define XB_SPIN(cond, bar) do { unsigned _sp = 0; while (cond) { __builtin_amdgcn_s_sleep(1); \
    if ((++_sp & 255u) == 0u) { if (xb_ld(&(bar)[XB_TMO])) break; if (_sp > XB_SPIN_CAP) { atomicAdd(&(bar)[XB_TMO], 1u); break; } } } } while (0)

struct XcdBarrier {
    unsigned* bar; unsigned x;
    volatile LAS unsigned* st;
};

__device__ __forceinline__ XcdBarrier xcd_barrier_post(unsigned* bar, volatile LAS unsigned* st) {
    XcdBarrier b; b.bar = bar; b.x = xb_xcc_id(); b.st = st;
    if (threadIdx.x == 0) (void)xb_add(&bar[XB_XCNT(b.x)], 1u);
    return b;
}
__device__ __forceinline__ void xcd_barrier_complete(unsigned* bar, unsigned x, unsigned& nloc, unsigned& nx) {
    const unsigned G = gridDim.x * gridDim.y * gridDim.z;
    unsigned sum, cnt, mine, sp = 0u;
    for (;;) {
        sum = 0u; cnt = 0u; mine = 0u;
#pragma unroll
        for (unsigned j = 0; j < 16; ++j) { const unsigned c = xb_ld(&bar[XB_XCNT(j)]); sum += c; cnt += (c > 0u) ? 1u : 0u; mine = (j == x) ? c : mine; }
        if (sum == G) break;
        __builtin_amdgcn_s_sleep(1);
        if ((++sp & 255u) == 0u) { if (xb_ld(&bar[XB_TMO])) break; if (sp > XB_SPIN_CAP) { atomicAdd(&bar[XB_TMO], 1u); break; } }
    }
    nloc = mine > 0u ? mine : 1u; nx = cnt > 0u ? cnt : 1u;
}

__device__ __forceinline__ void xcd_barrier(const XcdBarrier& b) {
    asm volatile("s_waitcnt vmcnt(0)" ::: "memory");
    __syncthreads();
    if (threadIdx.x == 0) {
        unsigned* bar = b.bar;
        __builtin_amdgcn_s_waitcnt(0);
        unsigned nloc = b.st[0], nx = b.st[1];
        if (nloc == 0u) { xcd_barrier_complete(bar, b.x, nloc, nx); b.st[0] = nloc; b.st[1] = nx; }
        const unsigned old = xb_add(&bar[XB_XSUB(b.x)], 1u);
        const unsigned gen = old / nloc;
        if (old + 1u == (gen + 1u) * nloc) {
            __builtin_amdgcn_fence(__ATOMIC_RELEASE, "agent");
            asm volatile("s_waitcnt vmcnt(0)" ::: "memory");
            const unsigned og = xb_add(&bar[XB_TOP], 1u);
            const unsigned tg = og / nx;
            if (og + 1u == (tg + 1u) * nx) xb_add(&bar[XB_TOPGEN], 1u);
            else XB_SPIN(xb_ld(&bar[XB_TOPGEN]) == tg, bar);
            __builtin_amdgcn_fence(__ATOMIC_ACQUIRE, "agent");
            xb_add(&bar[XB_XGEN(b.x)], 1u);
            asm volatile("s_waitcnt vmcnt(0)" ::: "memory");
        } else {
            XB_SPIN(xb_ld(&bar[XB_XGEN(b.x)]) == gen, bar);
            __builtin_amdgcn_fence(__ATOMIC_ACQUIRE, "agent");
            asm volatile("s_waitcnt vmcnt(0)" ::: "memory");
        }
    }
    __syncthreads();
}


#define GSYNC() do { asm volatile("s_waitcnt vmcnt(0) lgkmcnt(0)" ::: "memory"); grid.sync(); asm volatile("" ::: "memory"); } while (0)
static_assert(TICKET_WORD0 == XCD_BAR_WORDS, "ticket words follow the barrier words");
#define XSYNC() do { asm volatile("s_waitcnt lgkmcnt(0)" ::: "memory"); xcd_barrier(xbar); asm volatile("" ::: "memory"); } while (0)
#define LAUNDER(c) do { int t_ = threadIdx.x; asm volatile("" : "+v"(t_)); (c).tid = t_; (c).lane = t_ & 63; (c).wave = __builtin_amdgcn_readfirstlane(t_ >> 6); \
        (c).gtid = blockIdx.x * NTHR + t_; (c).gwave = blockIdx.x * 8 + (c).wave; } while (0)
__global__ void __launch_bounds__(NTHR) fwd_kernel(Params p) {
    extern __shared__ __attribute__((aligned(16))) unsigned char lds_raw[];
    cg::grid_group grid = cg::this_grid();
    Ctx c;
    c.p = p; c.ws = p.ws; c.lds = (LAS unsigned char*)lds_raw;
    c.tid = threadIdx.x; c.lane = c.tid & 63; c.wave = __builtin_amdgcn_readfirstlane(c.tid >> 6);
    c.gtid = blockIdx.x * NTHR + c.tid; c.gthreads = gridDim.x * NTHR; c.gwave = blockIdx.x * 8 + c.wave; c.gwaves = gridDim.x * 8;
    u16* xn = (u16*)(p.ws + WS_XN);
    u16* proj = (u16*)(p.ws + WS_R1);
    volatile LAS unsigned* xst = (volatile LAS unsigned*)(c.lds + 131072);
    if (c.tid == 0) { xst[0] = 0u; xst[1] = 0u; }
    __syncthreads();
    const XcdBarrier xbar = xcd_barrier_post((unsigned*)(p.ws + WS_BAR), xst);
    GSYNC();
    for (int l = 0; l < DEPTH; ++l) {
        const float* xcur = l == 0 ? p.in[I_X] : p.out;
        LAUNDER(c);
        if (l == 0) phase_rope_table(c);
        LAUNDER(c);
        phase_wconv(c, l);
        LAUNDER(c);
        phase_rmsnorm(c, xcur, p.in[I_N1G] + l * 1024, xn);
        XSYNC();
        LAUNDER(c);
        g8::gemm_phase(c.lds, c.tid, xn, 1024, (const u16*)(p.ws + WS_BT_IN), 1024, NTOK / 256, INWP / 256, g8::EpiBf16{proj, INWP});
        XSYNC();
        LAUNDER(c);
        g8::gemm_phase(c.lds, c.tid, proj + 1280, INWP, (const u16*)(p.ws + WS_BT_MLA), 512, NTOK / 256, 4, g8::EpiBf16{xn, 1024});
        XSYNC();
        LAUNDER(c);
        phase_pp(c, l);
        XSYNC();
        LAUNDER(c);
        phase_attn(c, l);
        XSYNC();
        LAUNDER(c);
        phase_dmerge(c);
        XSYNC();
        LAUNDER(c);
        g8::gemm_phase(c.lds, c.tid, (const u16*)(p.ws + WS_MIX), 1024, (const u16*)(p.ws + WS_BT_OUT), 1024, NTOK / 256, 4, g8::EpiRes{xcur, p.out});
        XSYNC();
        LAUNDER(c);
        phase_rmsnorm(c, p.out, p.in[I_N2G] + l * 1024, xn);
        XSYNC();
        LAUNDER(c);
        g8::gemm_phase(c.lds, c.tid, xn, 1024, (const u16*)(p.ws + WS_BT_UP), 1024, NTOK / 256, 22,
                       g8::EpiConv{(u16*)(p.ws + WS_ACT), (u16*)(p.ws + WS_HB), p.in[I_CONVW] + (size_t)l * 3 * 5632, p.in[I_CONVB] + (size_t)l * 5632});
        XSYNC();
        LAUNDER(c);
        phase_ffn_fixup(c, l);
        XSYNC();
        LAUNDER(c);
        g8::gemm_phase(c.lds, c.tid, (const u16*)(p.ws + WS_ACT), DFF, (const u16*)(p.ws + WS_BT_DN), DFF, NTOK / 256, 4, g8::EpiRes{p.out, p.out});
        XSYNC();
    }
}

extern "C" void kernel_launch(void* const* d_in, const int* in_sizes, int n_in, void* d_out, int out_size, void* d_ws, size_t ws_size,
                              hipStream_t stream) {
    static int grid_blocks = 0;
    if (!grid_blocks) {
        int dev = 0, cus = 0, per_cu = 0;
        (void)hipGetDevice(&dev);
        (void)hipDeviceGetAttribute(&cus, hipDeviceAttributeMultiprocessorCount, dev);
        (void)hipFuncSetAttribute((const void*)fwd_kernel, hipFuncAttributeMaxDynamicSharedMemorySize, LDS_BYTES);
        (void)hipOccupancyMaxActiveBlocksPerMultiprocessor(&per_cu, (const void*)fwd_kernel, NTHR, LDS_BYTES);
        if (per_cu < 1) per_cu = 1;
        grid_blocks = cus * per_cu;
        if (ws_size < WS_END || n_in != 26) fprintf(stderr, "kernel_launch: unexpected ws_size %zu (need %zu) or n_in %d\n", ws_size, (size_t)WS_END, n_in);
    }
    (void)hipMemsetAsync((unsigned char*)d_ws + WS_BAR, 0, (XCD_BAR_WORDS + 64 * DEPTH) * sizeof(unsigned), stream);
    Params p{};
    for (int i = 0; i < 26 && i < n_in; ++i) p.in[i] = (const float*)d_in[i];
    p.out = (float*)d_out;
    p.ws = (unsigned char*)d_ws;
    void* args[] = {&p};
    hipError_t e = hipLaunchCooperativeKernel((const void*)fwd_kernel, dim3(grid_blocks), dim3(NTHR), args, LDS_BYTES, stream);
    if (e != hipSuccess) fprintf(stderr, "cooperative launch failed: %s (grid %d)\n", hipGetErrorString(e), grid_blocks);
}
```
